# Optimizing an MI355X kernel written in HIP

```python
import jax, jax.numpy as jnp
from jax import lax
import numpy as np

D_MODEL = 2048
BATCH = 2
SEQ = 8192
DEPTH = 4

HEAD_DIM = 128
SG_WIDTH = D_MODEL // 4
SG_HEADS = SG_WIDTH // HEAD_DIM
SG_CHUNK = 128
POOL_WINDOWS = (2, 4, 8, 16)
POOL_GROUPS = len(POOL_WINDOWS)
POOL_WIDTH = D_MODEL // 4
POOL_CH = POOL_WIDTH // POOL_GROUPS
NA_WIDTH = D_MODEL // 2
NA_HEADS = NA_WIDTH // HEAD_DIM
NA_KH = 8
NA_KW = 16
GRID_W = 64
MIX_WIDTH = SG_WIDTH + POOL_WIDTH + NA_WIDTH
IN_COLS = 2 * SG_WIDTH + POOL_WIDTH + 3 * NA_WIDTH
D_FF = 11 * D_MODEL // 4
EPS = 1e-6
NEG = -1e30

kernel_name = "hybrid_gmlp_pool_natten_macaron_encoder"


def rms_norm(x, g):
    xf = x.astype(jnp.float32)
    y = xf * lax.rsqrt(jnp.mean(xf * xf, axis=-1, keepdims=True) + EPS)
    return (y * g.astype(jnp.float32)).astype(x.dtype)


def swiglu(h, w_gate, w_up, w_down):
    return (jax.nn.silu(h @ w_gate) * (h @ w_up)) @ w_down


def spatial_gating(zu, zv, g, w_s, b_s):
    B, S, _ = zu.shape
    u = jax.nn.gelu(zu, approximate=False)
    v = jax.nn.gelu(zv, approximate=False).reshape(B, S // SG_CHUNK, SG_CHUNK, SG_HEADS, HEAD_DIM)
    v = rms_norm(v, g.reshape(SG_HEADS, HEAD_DIM))
    mixed = jnp.einsum('hpq,bnqhd->bnphd', w_s, v) + b_s.T[None, None, :, :, None]
    return u * mixed.reshape(B, S, SG_WIDTH)


def multiscale_pool(p, w, scale):
    B, S, _ = p.shape
    pf = p.astype(jnp.float32).reshape(B, S, POOL_GROUPS, POOL_CH)
    cs = jnp.concatenate([jnp.zeros((B, 1, POOL_GROUPS, POOL_CH), jnp.float32),
                          jnp.cumsum(pf, axis=1)], axis=1)
    t = jnp.arange(S)
    outs = []
    for g, win in enumerate(POOL_WINDOWS):
        lo = jnp.clip(t - win // 2, 0, S)
        hi = jnp.clip(t + win // 2, 0, S)
        cnt = (hi - lo).astype(jnp.float32)
        mean = (cs[:, hi, g] - cs[:, lo, g]) / cnt[None, :, None]
        outs.append(mean - pf[:, :, g])
    d = jnp.stack(outs, axis=2).astype(p.dtype)
    y = jnp.einsum('bsgc,gcd->bsgd', d, w) * scale.reshape(POOL_GROUPS, POOL_CH)
    return y.reshape(B, S, POOL_WIDTH)


def neighbourhood_attention(q, k, v, rpb):
    B, S, H, Dh = q.shape
    rows = S // GRID_W
    kh = min(NA_KH, rows)
    qg = q.reshape(B, rows, GRID_W, H, Dh)
    kg = k.reshape(B, rows, GRID_W, H, Dh)
    vg = v.reshape(B, rows, GRID_W, H, Dh)
    col = jnp.arange(GRID_W)
    col_start = jnp.clip(col - NA_KW // 2, 0, GRID_W - NA_KW)
    col_in = (col[None, :] >= col_start[:, None]) & (col[None, :] < col_start[:, None] + NA_KW)
    dc_idx = jnp.clip(col[None, :] - col[:, None] + NA_KW - 1, 0, 2 * NA_KW - 2)
    rpb_col = rpb.astype(jnp.float32)[:, :, dc_idx]
    scale = Dh ** -0.5

    def one_row(r):
        sr = jnp.clip(r - kh // 2, 0, rows - kh)
        q_r = lax.dynamic_index_in_dim(qg, r, axis=1, keepdims=False)
        k_r = lax.dynamic_slice_in_dim(kg, sr, kh, axis=1)
        v_r = lax.dynamic_slice_in_dim(vg, sr, kh, axis=1)
        dr = sr + jnp.arange(kh) - r + NA_KH - 1
        bias = jnp.take(rpb_col, dr, axis=1).transpose(0, 2, 1, 3)
        s = jnp.einsum('bqhd,bjkhd->bhqjk', q_r, k_r).astype(jnp.float32) * scale + bias[None]
        s = jnp.where(col_in[:, None, :], s, NEG)
        pr = jax.nn.softmax(s.reshape(B, H, GRID_W, kh * GRID_W), axis=-1)
        pr = pr.reshape(B, H, GRID_W, kh, GRID_W).astype(v.dtype)
        return jnp.einsum('bhqjk,bjkhd->bqhd', pr, v_r)

    out = lax.map(one_row, jnp.arange(rows))
    return out.transpose(1, 0, 2, 3, 4).reshape(B, S, H, Dh)


def setup_inputs(seed: int = 0) -> dict:
    key = jax.random.key(seed)
    ks = jax.random.split(key, 20)
    f32 = jnp.float32
    nrm = lambda k, shape, s: jax.random.normal(k, shape, f32) * s
    L = DEPTH
    return {
        "x": jax.random.normal(ks[0], (BATCH, SEQ, D_MODEL), f32),
        "ffn1_norm": 1.0 + nrm(ks[1], (L, D_MODEL), 0.05),
        "ffn1_w_gate": nrm(ks[2], (L, D_MODEL, D_FF), D_MODEL ** -0.5),
        "ffn1_w_up": nrm(ks[3], (L, D_MODEL, D_FF), D_MODEL ** -0.5),
        "ffn1_w_down": nrm(ks[4], (L, D_FF, D_MODEL), D_FF ** -0.5),
        "mix_norm": 1.0 + nrm(ks[5], (L, D_MODEL), 0.05),
        "w_in": nrm(ks[6], (L, D_MODEL, IN_COLS), D_MODEL ** -0.5),
        "sg_norm": 1.0 + nrm(ks[7], (L, SG_WIDTH), 0.05),
        "sg_w": nrm(ks[8], (L, SG_HEADS, SG_CHUNK, SG_CHUNK), SG_CHUNK ** -0.5),
        "sg_b": 1.0 + nrm(ks[9], (L, SG_HEADS, SG_CHUNK), 0.05),
        "pool_w": nrm(ks[10], (L, POOL_GROUPS, POOL_CH, POOL_CH), POOL_CH ** -0.5),
        "pool_scale": 1.0 + nrm(ks[11], (L, POOL_WIDTH), 0.1),
        "na_rpb": nrm(ks[12], (L, NA_HEADS, 2 * NA_KH - 1, 2 * NA_KW - 1), 0.1),
        "w_out": nrm(ks[13], (L, MIX_WIDTH, D_MODEL), MIX_WIDTH ** -0.5),
        "ffn2_norm": 1.0 + nrm(ks[14], (L, D_MODEL), 0.05),
        "ffn2_w_gate": nrm(ks[15], (L, D_MODEL, D_FF), D_MODEL ** -0.5),
        "ffn2_w_up": nrm(ks[16], (L, D_MODEL, D_FF), D_MODEL ** -0.5),
        "ffn2_w_down": nrm(ks[17], (L, D_FF, D_MODEL), D_FF ** -0.5),
        "final_norm": 1.0 + nrm(ks[18], (D_MODEL,), 0.05),
    }


def reference(x, ffn1_norm, ffn1_w_gate, ffn1_w_up, ffn1_w_down, mix_norm, w_in,
              sg_norm, sg_w, sg_b, pool_w, pool_scale, na_rpb, w_out,
              ffn2_norm, ffn2_w_gate, ffn2_w_up, ffn2_w_down, final_norm):
    B, S, _ = x.shape
    splits = [SG_WIDTH, 2 * SG_WIDTH, 2 * SG_WIDTH + POOL_WIDTH,
              2 * SG_WIDTH + POOL_WIDTH + NA_WIDTH, 2 * SG_WIDTH + POOL_WIDTH + 2 * NA_WIDTH]
    for l in range(DEPTH):
        x = x + 0.5 * swiglu(rms_norm(x, ffn1_norm[l]), ffn1_w_gate[l], ffn1_w_up[l], ffn1_w_down[l])
        h = rms_norm(x, mix_norm[l])
        z = h @ w_in[l]
        zu, zv, zp, zq, zk, zvv = jnp.split(z, splits, axis=-1)
        a = spatial_gating(zu, zv, sg_norm[l], sg_w[l], sg_b[l])
        bp = multiscale_pool(zp, pool_w[l], pool_scale[l])
        c = neighbourhood_attention(zq.reshape(B, S, NA_HEADS, HEAD_DIM),
                                    zk.reshape(B, S, NA_HEADS, HEAD_DIM),
                                    zvv.reshape(B, S, NA_HEADS, HEAD_DIM),
                                    na_rpb[l]).reshape(B, S, NA_WIDTH)
        x = x + jnp.concatenate([a, bp, c], axis=-1) @ w_out[l]
        x = x + 0.5 * swiglu(rms_norm(x, ffn2_norm[l]), ffn2_w_gate[l], ffn2_w_up[l], ffn2_w_down[l])
    return rms_norm(x, final_norm)
```

```cpp
#include <hip/hip_runtime.h>
#include <cstdio>
#include <cstdint>

namespace pg8 {
#define PG8_LAS __attribute__((address_space(3)))
#define PG8_GAS __attribute__((address_space(1)))
typedef unsigned short bf16_t;
typedef short bf16x8 __attribute__((ext_vector_type(8)));
typedef float f32x4 __attribute__((ext_vector_type(4)));
typedef float f32x2 __attribute__((ext_vector_type(2)));
typedef unsigned u32x4 __attribute__((ext_vector_type(4)));
typedef unsigned u32x2 __attribute__((ext_vector_type(2)));
constexpr int BM = 256, BK = 64, HALF = 128, HTB = HALF * BK * 2  , STAGE_BYTES = 8 * HTB, NXCD = 8, WGM = 4;

__host__ __device__ __forceinline__ int lds_byte(int r, int c) { const int st = (r >> 4) * 2 + (c >> 5), rr = r & 15, cc = c & 31, ob = rr * 64 + cc * 2; return st * 1024 + (ob ^ (((ob >> 9) & 1) << 5)); }
__host__ __device__ __forceinline__ void stage_rc(int b, int& R, int& C) { const int st = b / 1024, sb = b % 1024, swz = sb ^ (((sb >> 9) & 1) << 5); R = (st >> 1) * 16 + swz / 64; C = (st & 1) * 32 + (swz % 64) / 2; }
__host__ __device__ __forceinline__ int perm32(int rho) { const int n = rho >> 4, i = rho & 15; return 8 * (i >> 2) + 4 * n + (i & 3); }

struct Unit { int pm, pn; };
struct Gemm { const PG8_GAS bf16_t* A; const PG8_GAS bf16_t* Bt; int M, N, K; };

struct StaticOrder {
    int nM, nN, nwg, G, c, wgm;
    __host__ __device__ void init(int M, int N, int G_, int c_, int wgm_ = WGM) { nM = M / BM; nN = N / BM; nwg = nM * nN; G = G_; c = c_; wgm = wgm_; }
    __host__ __device__ bool next(int i, Unit& u) const {
        const long L = (long)i * G + c; if (L >= nwg) return false;
        int wgid = (int)L; { const int q = nwg / NXCD, r = nwg % NXCD, xcd = wgid % NXCD, off = wgid / NXCD; wgid = (xcd < r ? xcd * (q + 1) : r * (q + 1) + (xcd - r) * q) + off; }
        const int nig = wgm * nN, gid = wgid / nig, fm = gid * wgm, gsz = (nM - fm) < wgm ? (nM - fm) : wgm;
        u.pm = fm + ((wgid % nig) % gsz); u.pn = (wgid % nig) / gsz; return true;
    }
    __device__ __forceinline__ void a_ready(const Unit&) const {}
    __device__ __forceinline__ void done(const Unit&) const {}
};

__device__ __forceinline__ unsigned cvt_pk_bf16(float lo, float hi) { unsigned r; asm volatile("v_cvt_pk_bf16_f32 %0, %1, %2" : "=v"(r) : "v"(lo), "v"(hi)); return r; }
__device__ __forceinline__ f32x2 gelu_pk(f32x2 v) {
    const f32x2 av = __builtin_elementwise_abs(v), d = av * 0.2316418882f + 1.0f;
    f32x2 t; t.x = __builtin_amdgcn_rcpf(d.x); t.y = __builtin_amdgcn_rcpf(d.y);
    f32x2 q = t * 0.5307027145f + (-0.7265760135f); q = q * t + 0.7107068705f; q = q * t + (-0.142248368f); q = q * t + 0.127414796f; q = q * t;
    const f32x2 s = (v * v) * (-0.72134752044f);
    f32x2 e; e.x = __builtin_amdgcn_exp2f(s.x); e.y = __builtin_amdgcn_exp2f(s.y);
    const f32x2 m = v * (q * e), r = v - m;
    f32x2 o; o.x = v.x < 0.f ? m.x : r.x; o.y = v.y < 0.f ? m.y : r.y; return o;
}
__device__ __forceinline__ float silu_mul(float g, float u) {
    const float e = __builtin_amdgcn_exp2f(g * -1.44269504089f);
    return g * __builtin_amdgcn_rcpf(1.0f + e) * u;
}
constexpr float RMS_EPS = 1e-6f;
__device__ __forceinline__ float row_rstd(const PG8_GAS float* ssq, int row) {
    const f32x4 a = *(const PG8_GAS f32x4*)(ssq + (size_t)row * 8), b = *(const PG8_GAS f32x4*)(ssq + (size_t)row * 8 + 4);
    const float s = ((a.x + a.y) + (a.z + a.w)) + ((b.x + b.y) + (b.z + b.w));
    return __builtin_amdgcn_rsqf(s * (1.0f / 2048.0f) + RMS_EPS);
}

__device__ __forceinline__ void rows_rstd8(const PG8_GAS float* ssq, int row0, float (&rsv)[2][4]) {
    f32x4 pa[2][4], pb[2][4];
#pragma unroll
    for (int ai = 0; ai < 2; ++ai)
#pragma unroll
        for (int m = 0; m < 4; ++m) { const PG8_GAS f32x4* p = (const PG8_GAS f32x4*)(ssq + (size_t)(row0 + ai * HALF + m * 16) * 8); pa[ai][m] = p[0]; pb[ai][m] = p[1]; }
    __builtin_amdgcn_sched_barrier(0);
#pragma unroll
    for (int ai = 0; ai < 2; ++ai)
#pragma unroll
        for (int m = 0; m < 4; ++m) { const f32x4 a = pa[ai][m], b = pb[ai][m]; const float s = ((a.x + a.y) + (a.z + a.w)) + ((b.x + b.y) + (b.z + b.w));
            rsv[ai][m] = __builtin_amdgcn_rsqf(s * (1.0f / 2048.0f) + RMS_EPS); }
}
constexpr int RRL_MAX = 11;
struct RowRstdLds {
    const PG8_GAS float* ssq; PG8_LAS float* tab;
    template <class Sched> __device__ __forceinline__ void prep_all(const Sched& S, int tid) const {
        if (tid < 256) { f32x4 pa[RRL_MAX], pb[RRL_MAX];
#pragma unroll
            for (int i = 0; i < RRL_MAX; ++i) { Unit u; const bool ok = S.next(i, u); const int row = (ok ? u.pm : 0) * BM + tid; const PG8_GAS f32x4* p = (const PG8_GAS f32x4*)(ssq + (size_t)row * 8); pa[i] = p[0]; pb[i] = p[1]; }
            __builtin_amdgcn_sched_barrier(0);
#pragma unroll
            for (int i = 0; i < RRL_MAX; ++i) { const f32x4 a = pa[i], b = pb[i]; const float s = ((a.x + a.y) + (a.z + a.w)) + ((b.x + b.y) + (b.z + b.w)); tab[i * 256 + tid] = __builtin_amdgcn_rsqf(s * (1.0f / 2048.0f) + RMS_EPS); } }
    }
};

struct EpiGateUp {
    static constexpr bool PERM = true, AFTER_DRAIN = false, ROW_RSTD_LDS = true;
    PG8_GAS bf16_t* O; int ldo; RowRstdLds R;
    __device__ __forceinline__ void operator()(const f32x4 (&acc)[2][2][4][2], const Unit& u, int wr, int wc, int fr, int fq, int ui) const {
        const int row0 = u.pm * BM + wr * 64 + fr, col0 = u.pn * HALF + wc * 32 + 8 * fq;
        float rsv[2][4];
        if (ui < RRL_MAX) { const PG8_LAS float* rt = R.tab + ui * 256 + wr * 64 + fr;
#pragma unroll
            for (int ai = 0; ai < 2; ++ai)
#pragma unroll
                for (int m = 0; m < 4; ++m) rsv[ai][m] = rt[ai * HALF + m * 16]; }
        else rows_rstd8(R.ssq, row0, rsv);
#pragma unroll
        for (int ai = 0; ai < 2; ++ai)
#pragma unroll
            for (int m = 0; m < 4; ++m) { const int row = row0 + ai * HALF + m * 16; const float rs = rsv[ai][m], rs2 = rs * rs, cg = rs * -1.44269504089f;
                u32x4 w;
#pragma unroll
                for (int n = 0; n < 2; ++n) { const f32x4 g = acc[ai][0][m][n], u = acc[ai][1][m][n]; const f32x4 a = g * cg; f32x4 e;
                    e[0] = __builtin_amdgcn_exp2f(a[0]); e[1] = __builtin_amdgcn_exp2f(a[1]); e[2] = __builtin_amdgcn_exp2f(a[2]); e[3] = __builtin_amdgcn_exp2f(a[3]);
                    const f32x4 d = e + 1.0f; f32x4 r;
                    r[0] = __builtin_amdgcn_rcpf(d[0]); r[1] = __builtin_amdgcn_rcpf(d[1]); r[2] = __builtin_amdgcn_rcpf(d[2]); r[3] = __builtin_amdgcn_rcpf(d[3]);
                    const f32x4 o = ((g * u) * rs2) * r;
                    if (n == 0) { w.x = cvt_pk_bf16(o[0], o[1]); w.y = cvt_pk_bf16(o[2], o[3]); } else { w.z = cvt_pk_bf16(o[0], o[1]); w.w = cvt_pk_bf16(o[2], o[3]); } }
                *(PG8_GAS u32x4*)(O + (size_t)row * ldo + col0) = w; }
    }
};
struct EpiZ {
    static constexpr bool PERM = true, AFTER_DRAIN = false, ROW_RSTD_LDS = true;
    PG8_GAS bf16_t* O; int ldo; RowRstdLds R;
    __device__ __forceinline__ void operator()(const f32x4 (&acc)[2][2][4][2], const Unit& u, int wr, int wc, int fr, int fq, int ui) const {
        const int row0 = u.pm * BM + wr * 64 + fr, col0 = u.pn * BM + wc * 32 + 8 * fq;
        float rsv[2][4];
        if (ui < RRL_MAX) { const PG8_LAS float* rt = R.tab + ui * 256 + wr * 64 + fr;
#pragma unroll
            for (int ai = 0; ai < 2; ++ai)
#pragma unroll
                for (int m = 0; m < 4; ++m) rsv[ai][m] = rt[ai * HALF + m * 16]; }
        else rows_rstd8(R.ssq, row0, rsv);
#pragma unroll
        for (int ai = 0; ai < 2; ++ai)
#pragma unroll
            for (int m = 0; m < 4; ++m) { const int row = row0 + ai * HALF + m * 16; const float rs = rsv[ai][m]; PG8_GAS bf16_t* rowp = O + (size_t)row * ldo + col0;
#pragma unroll
                for (int bj = 0; bj < 2; ++bj) { const f32x4 v0 = acc[ai][bj][m][0] * rs, v1 = acc[ai][bj][m][1] * rs;
                    u32x4 w; w.x = cvt_pk_bf16(v0[0], v0[1]); w.y = cvt_pk_bf16(v0[2], v0[3]); w.z = cvt_pk_bf16(v1[0], v1[1]); w.w = cvt_pk_bf16(v1[2], v1[3]);
                    *(PG8_GAS u32x4*)(rowp + bj * HALF) = w; } }
    }
};
struct EpiVT {
    static constexpr bool PERM = true, AFTER_DRAIN = false, ROW_RSTD_LDS = false;
    PG8_GAS bf16_t* O; const PG8_GAS float* ssq;
    __device__ __forceinline__ void operator()(const f32x4 (&acc)[2][2][4][2], const Unit& u, int wr, int wc, int fr, int fq) const {
        const int row0 = u.pm * BM + wr * 64 + fr, tok0 = u.pn * BM + wc * 32 + 8 * fq;
        const int b = tok0 >> 13, s0 = tok0 & 8191;
#pragma unroll
        for (int bj = 0; bj < 2; ++bj) { float rs[8];
            { f32x4 pa[8], pb[8];
#pragma unroll
              for (int j = 0; j < 8; ++j) { const PG8_GAS f32x4* p = (const PG8_GAS f32x4*)(ssq + (size_t)(tok0 + bj * HALF + j) * 8); pa[j] = p[0]; pb[j] = p[1]; }
              __builtin_amdgcn_sched_barrier(0);
#pragma unroll
              for (int j = 0; j < 8; ++j) { const f32x4 a = pa[j], b = pb[j]; const float s = ((a.x + a.y) + (a.z + a.w)) + ((b.x + b.y) + (b.z + b.w)); rs[j] = __builtin_amdgcn_rsqf(s * (1.0f / 2048.0f) + RMS_EPS); } }
#pragma unroll
            for (int ai = 0; ai < 2; ++ai)
#pragma unroll
                for (int m = 0; m < 4; ++m) { const int n = row0 + ai * HALF + m * 16; const f32x4 v0 = acc[ai][bj][m][0], v1 = acc[ai][bj][m][1];
                    u32x4 w; w.x = cvt_pk_bf16(v0[0] * rs[0], v0[1] * rs[1]); w.y = cvt_pk_bf16(v0[2] * rs[2], v0[3] * rs[3]); w.z = cvt_pk_bf16(v1[0] * rs[4], v1[1] * rs[5]); w.w = cvt_pk_bf16(v1[2] * rs[6], v1[3] * rs[7]);
                    *(PG8_GAS u32x4*)(O + ((size_t)(b * 1024 + n) * 8192 + s0 + bj * HALF)) = w; } }
    }
};
struct EpiResid {
    static constexpr bool PERM = true, AFTER_DRAIN = false, ROW_RSTD_LDS = false;
    PG8_GAS float* Xf; PG8_GAS bf16_t* XB; PG8_GAS float* ssq; float scale; PG8_LAS float* scr; int tid;
    __device__ __forceinline__ void operator()(const f32x4 (&acc)[2][2][4][2], const Unit& u, int wr, int wc, int fr, int fq) const {
        const int row0 = u.pm * BM + wr * 64 + fr, col0 = u.pn * BM + wc * 32 + 8 * fq;
        PG8_GAS bf16_t* bp0 = XB + (size_t)row0 * 2048 + col0;
        u32x4 xo[2][4][2];
#pragma unroll
        for (int ai = 0; ai < 2; ++ai)
#pragma unroll
            for (int m = 0; m < 4; ++m)
#pragma unroll
                for (int bj = 0; bj < 2; ++bj) xo[ai][m][bj] = *(const PG8_GAS u32x4*)(bp0 + (size_t)(ai * HALF + m * 16) * 2048 + bj * HALF);
        float ssv[2][4];
#pragma unroll
        for (int ai = 0; ai < 2; ++ai)
#pragma unroll
            for (int m = 0; m < 4; ++m) { float ss = 0.f;
#pragma unroll
                for (int bj = 0; bj < 2; ++bj) { const u32x4 x = xo[ai][m][bj];
                    f32x4 y0, y1;
                    y0[0] = __builtin_bit_cast(float, x.x << 16) + acc[ai][bj][m][0][0] * scale; y0[1] = __builtin_bit_cast(float, x.x & 0xffff0000u) + acc[ai][bj][m][0][1] * scale;
                    y0[2] = __builtin_bit_cast(float, x.y << 16) + acc[ai][bj][m][0][2] * scale; y0[3] = __builtin_bit_cast(float, x.y & 0xffff0000u) + acc[ai][bj][m][0][3] * scale;
                    y1[0] = __builtin_bit_cast(float, x.z << 16) + acc[ai][bj][m][1][0] * scale; y1[1] = __builtin_bit_cast(float, x.z & 0xffff0000u) + acc[ai][bj][m][1][1] * scale;
                    y1[2] = __builtin_bit_cast(float, x.w << 16) + acc[ai][bj][m][1][2] * scale; y1[3] = __builtin_bit_cast(float, x.w & 0xffff0000u) + acc[ai][bj][m][1][3] * scale;
                    u32x4 w; w.x = cvt_pk_bf16(y0[0], y0[1]); w.y = cvt_pk_bf16(y0[2], y0[3]); w.z = cvt_pk_bf16(y1[0], y1[1]); w.w = cvt_pk_bf16(y1[2], y1[3]);
                    *(PG8_GAS u32x4*)(bp0 + (size_t)(ai * HALF + m * 16) * 2048 + bj * HALF) = w;
                    ss += ((y0[0] * y0[0] + y0[1] * y0[1]) + (y0[2] * y0[2] + y0[3] * y0[3])) + ((y1[0] * y1[0] + y1[1] * y1[1]) + (y1[2] * y1[2] + y1[3] * y1[3])); }
                ssv[ai][m] = ss; }
        { float t[2][4];
#pragma unroll
          for (int ai = 0; ai < 2; ++ai)
#pragma unroll
              for (int m = 0; m < 4; ++m) t[ai][m] = __shfl_xor(ssv[ai][m], 16);
#pragma unroll
          for (int ai = 0; ai < 2; ++ai)
#pragma unroll
              for (int m = 0; m < 4; ++m) ssv[ai][m] += t[ai][m];
#pragma unroll
          for (int ai = 0; ai < 2; ++ai)
#pragma unroll
              for (int m = 0; m < 4; ++m) t[ai][m] = __shfl_xor(ssv[ai][m], 32);
#pragma unroll
          for (int ai = 0; ai < 2; ++ai)
#pragma unroll
              for (int m = 0; m < 4; ++m) { if (fq == 0) scr[(ai * HALF + wr * 64 + m * 16 + fr) * 4 + wc] = ssv[ai][m] + t[ai][m]; } }
        if (Xf) {
            PG8_GAS float* xp0 = Xf + (size_t)row0 * 2048 + col0;
#pragma unroll
            for (int ai = 0; ai < 2; ++ai)
#pragma unroll
                for (int m = 0; m < 4; ++m)
#pragma unroll
                    for (int bj = 0; bj < 2; ++bj) { const u32x4 x = xo[ai][m][bj];
                        f32x4 y0, y1;
                        y0[0] = __builtin_bit_cast(float, x.x << 16) + acc[ai][bj][m][0][0] * scale; y0[1] = __builtin_bit_cast(float, x.x & 0xffff0000u) + acc[ai][bj][m][0][1] * scale;
                        y0[2] = __builtin_bit_cast(float, x.y << 16) + acc[ai][bj][m][0][2] * scale; y0[3] = __builtin_bit_cast(float, x.y & 0xffff0000u) + acc[ai][bj][m][0][3] * scale;
                        y1[0] = __builtin_bit_cast(float, x.z << 16) + acc[ai][bj][m][1][0] * scale; y1[1] = __builtin_bit_cast(float, x.z & 0xffff0000u) + acc[ai][bj][m][1][1] * scale;
                        y1[2] = __builtin_bit_cast(float, x.w << 16) + acc[ai][bj][m][1][2] * scale; y1[3] = __builtin_bit_cast(float, x.w & 0xffff0000u) + acc[ai][bj][m][1][3] * scale;
                        PG8_GAS float* xp = xp0 + (size_t)(ai * HALF + m * 16) * 2048 + bj * HALF; *(PG8_GAS f32x4*)xp = y0; *(PG8_GAS f32x4*)(xp + 4) = y1; }
        }
        asm volatile("s_waitcnt lgkmcnt(0)" ::: "memory"); __builtin_amdgcn_s_barrier(); asm volatile("" ::: "memory");
        if (tid < 256) { const f32x4 p = *(const PG8_LAS f32x4*)(scr + tid * 4); ssq[(size_t)(u.pm * BM + tid) * 8 + u.pn] = (p.x + p.y) + (p.z + p.w); }
    }
};

template <class Epi, class Sched, bool ALIGN_EPI = false, bool SP2 = false, bool KREV = false>
__device__ __forceinline__ void gemm_phase(PG8_LAS unsigned char* lds, const Gemm g, const Sched& S, const Epi& E, int tid_in) {
    int tid_ = tid_in; asm volatile("" : "+v"(tid_));
    const int tid = tid_, wid = __builtin_amdgcn_readfirstlane(tid >> 6), lane = tid & 63, wr = wid >> 2, wc = wid & 3, fr = lane & 15, fq = lane >> 4;
    const int K = g.K, nt = K / BK;
    unsigned voffA[2], voffB[2];
#pragma unroll
    for (int i = 0; i < 2; ++i) { int R, C; stage_rc(tid * 16 + i * 8192, R, C); const int Rb = Epi::PERM ? ((R & ~31) + perm32(R & 31)) : R;
        voffA[i] = (unsigned)(R * K + C) * 2u; voffB[i] = (unsigned)(Rb * K + C) * 2u; }
    const ptrdiff_t kstep = KREV ? -(ptrdiff_t)(BK * 2) : (ptrdiff_t)(BK * 2);
    const size_t hstep = (size_t)HALF * K * 2;
    const size_t tstep = 2 * hstep;
    const unsigned ldsw = (unsigned)wid * 1024u;
    const int aoff = lds_byte(wr * 64 + fr, fq * 8), boff = lds_byte(wc * 32 + fr, fq * 8);
#define PG8_SA(b, h) (((b) * 2 + (h)) * HTB)
#define PG8_SB(b, h) ((4 + (b) * 2 + (h)) * HTB)
#define PG8_STAGE(bufoff, gbase, voff) do { _Pragma("unroll") for (int _i = 0; _i < 2; ++_i) \
        __builtin_amdgcn_global_load_lds((const PG8_GAS unsigned*)((const PG8_GAS char*)(gbase) + (voff)[_i]), (PG8_LAS unsigned*)(lds + (bufoff) + ldsw + _i * 8192), 16, 0, 0); } while (0)
#define PG8_LDA(dst, b, h) do { _Pragma("unroll") for (int m = 0; m < 4; ++m) _Pragma("unroll") for (int k = 0; k < 2; ++k) dst[m][k] = *(const PG8_LAS bf16x8*)(lds + PG8_SA(b, h) + aoff + m * 2048 + k * 1024); } while (0)
#define PG8_LDB(dst, b, h) do { _Pragma("unroll") for (int n = 0; n < 2; ++n) _Pragma("unroll") for (int k = 0; k < 2; ++k) dst[n][k] = *(const PG8_LAS bf16x8*)(lds + PG8_SB(b, h) + boff + n * 2048 + k * 1024); } while (0)
#define PG8_MMA(ai, bj, At, Bt) do { __builtin_amdgcn_s_setprio(1); _Pragma("unroll") for (int m = 0; m < 4; ++m) _Pragma("unroll") for (int n = 0; n < 2; ++n) _Pragma("unroll") for (int k = 0; k < 2; ++k) \
        acc[ai][bj][m][n] = __builtin_amdgcn_mfma_f32_16x16x32_bf16(Bt[n][k], At[m][k], acc[ai][bj][m][n], 0, 0, 0); __builtin_amdgcn_s_setprio(0); } while (0)
#define PG8_WAIT_V(n) asm volatile("s_waitcnt vmcnt(" #n ")" ::: "memory")
#define PG8_WAIT_L(n) asm volatile("s_waitcnt lgkmcnt(" #n ")" ::: "memory")
#define PG8_BAR __builtin_amdgcn_s_barrier()
#define PG8_SCHED __builtin_amdgcn_sched_barrier(0)
    Unit cur, nxt; int ui = 0;
    if (!S.next(0, cur)) return;
    f32x4 acc[2][2][4][2];
#pragma unroll
    for (int a = 0; a < 2; ++a)
#pragma unroll
        for (int b = 0; b < 2; ++b)
#pragma unroll
            for (int m = 0; m < 4; ++m)
#pragma unroll
                for (int n = 0; n < 2; ++n) acc[a][b][m][n] = (f32x4){0.f, 0.f, 0.f, 0.f};
    bf16x8 At[4][2], B0[2][2], B1[2][2];
    const size_t k0off = KREV ? (size_t)(nt - 1) * (size_t)(BK * 2) : (size_t)0;
    const PG8_GAS char* cA = (const PG8_GAS char*)g.A + (size_t)cur.pm * tstep + k0off; const PG8_GAS char* cB = (const PG8_GAS char*)g.Bt + (size_t)cur.pn * tstep + k0off;
    S.a_ready(cur);
    if constexpr (Epi::ROW_RSTD_LDS) E.R.prep_all(S, tid);
    if constexpr (SP2) {
        PG8_STAGE(PG8_SB(0, 0), cB, voffB); PG8_STAGE(PG8_SB(0, 1), cB + hstep, voffB); PG8_STAGE(PG8_SA(0, 0), cA, voffA); PG8_STAGE(PG8_SA(0, 1), cA + hstep, voffA);
        if (wr == 1) PG8_BAR;
        PG8_WAIT_V(2); PG8_BAR;
        PG8_STAGE(PG8_SB(1, 0), cB + kstep, voffB); PG8_STAGE(PG8_SA(1, 0), cA + kstep, voffA); PG8_STAGE(PG8_SB(1, 1), cB + hstep + kstep, voffB);
        PG8_WAIT_V(6); PG8_BAR;
    } else {
        PG8_STAGE(PG8_SB(0, 0), cB, voffB); PG8_STAGE(PG8_SA(0, 0), cA, voffA); PG8_STAGE(PG8_SB(0, 1), cB + hstep, voffB); PG8_STAGE(PG8_SA(0, 1), cA + hstep, voffA);
        if (wr == 1) PG8_BAR;
        PG8_WAIT_V(4); PG8_BAR;
        PG8_STAGE(PG8_SB(1, 0), cB + kstep, voffB); PG8_STAGE(PG8_SA(1, 0), cA + kstep, voffA); PG8_STAGE(PG8_SB(1, 1), cB + hstep + kstep, voffB);
        PG8_WAIT_V(6); PG8_BAR;
    }
    for (;;) {
        const bool has_next = S.next(ui + 1, nxt);
        const PG8_GAS char* nA = has_next ? (const PG8_GAS char*)g.A + (size_t)nxt.pm * tstep + k0off : cA; const PG8_GAS char* nB = has_next ? (const PG8_GAS char*)g.Bt + (size_t)nxt.pn * tstep + k0off : cB;
        for (int t = 0; t < nt; t += 2) {
            const bool last = (t == nt - 2);
            const PG8_GAS char* a1 = cA + (ptrdiff_t)(t + 1) * kstep;
            const PG8_GAS char* a2 = last ? nA : cA + (ptrdiff_t)(t + 2) * kstep; const PG8_GAS char* b2 = last ? nB : cB + (ptrdiff_t)(t + 2) * kstep;
            const PG8_GAS char* a3 = a2 + kstep; const PG8_GAS char* b3 = b2 + kstep;
            if (last && has_next) S.a_ready(nxt);
            if constexpr (SP2) {
            PG8_LDB(B0, 0, 0); PG8_LDB(B1, 0, 1); PG8_SCHED; PG8_LDA(At, 0, 0); PG8_STAGE(PG8_SA(1, 1), a1 + hstep, voffA);
            PG8_WAIT_V(8); PG8_WAIT_L(0); PG8_BAR; PG8_MMA(0, 0, At, B0); PG8_MMA(0, 1, At, B1); PG8_BAR; PG8_SCHED;
            PG8_LDA(At, 0, 1); PG8_STAGE(PG8_SB(0, 0), b2, voffB); PG8_STAGE(PG8_SB(0, 1), b2 + hstep, voffB); PG8_STAGE(PG8_SA(0, 0), a2, voffA);
            PG8_WAIT_V(8); PG8_WAIT_L(0); PG8_BAR; PG8_MMA(1, 0, At, B0); PG8_MMA(1, 1, At, B1); PG8_BAR; PG8_SCHED;
            PG8_LDB(B0, 1, 0); PG8_LDB(B1, 1, 1); PG8_SCHED; PG8_LDA(At, 1, 0); PG8_STAGE(PG8_SA(0, 1), a2 + hstep, voffA);
            PG8_WAIT_V(8); PG8_WAIT_L(0); PG8_BAR; PG8_MMA(0, 0, At, B0); PG8_MMA(0, 1, At, B1); PG8_BAR; PG8_SCHED;
            PG8_LDA(At, 1, 1); PG8_STAGE(PG8_SB(1, 0), b3, voffB); PG8_STAGE(PG8_SB(1, 1), b3 + hstep, voffB); PG8_STAGE(PG8_SA(1, 0), a3, voffA);
            PG8_WAIT_V(8); PG8_WAIT_L(0); PG8_BAR; PG8_MMA(1, 0, At, B0); PG8_MMA(1, 1, At, B1); PG8_BAR; PG8_SCHED;
            } else {
            PG8_LDB(B0, 0, 0); PG8_SCHED; PG8_LDA(At, 0, 0); PG8_STAGE(PG8_SA(1, 1), a1 + hstep, voffA);
            PG8_WAIT_L(8); PG8_BAR; PG8_WAIT_L(0); PG8_MMA(0, 0, At, B0); PG8_BAR; PG8_SCHED;
            PG8_LDB(B1, 0, 1); PG8_STAGE(PG8_SB(0, 0), b2, voffB);
            PG8_BAR; PG8_WAIT_L(0); PG8_MMA(0, 1, At, B1); PG8_BAR;
            PG8_LDA(At, 0, 1); PG8_STAGE(PG8_SA(0, 0), a2, voffA);
            PG8_BAR; PG8_WAIT_L(0); PG8_MMA(1, 0, At, B0); PG8_BAR; PG8_SCHED;
            PG8_STAGE(PG8_SB(0, 1), b2 + hstep, voffB);
            PG8_WAIT_V(6); PG8_BAR; PG8_MMA(1, 1, At, B1); PG8_BAR;
            PG8_LDB(B0, 1, 0); PG8_SCHED; PG8_LDA(At, 1, 0); PG8_STAGE(PG8_SA(0, 1), a2 + hstep, voffA);
            PG8_WAIT_L(8); PG8_BAR; PG8_WAIT_L(0); PG8_MMA(0, 0, At, B0); PG8_BAR; PG8_SCHED;
            PG8_LDB(B1, 1, 1); PG8_STAGE(PG8_SB(1, 0), b3, voffB);
            PG8_BAR; PG8_WAIT_L(0); PG8_MMA(0, 1, At, B1); PG8_BAR;
            PG8_LDA(At, 1, 1); PG8_STAGE(PG8_SA(1, 0), a3, voffA);
            PG8_BAR; PG8_WAIT_L(0); PG8_MMA(1, 0, At, B0); PG8_BAR; PG8_SCHED;
            PG8_STAGE(PG8_SB(1, 1), b3 + hstep, voffB);
            PG8_WAIT_V(6); PG8_BAR; PG8_MMA(1, 1, At, B1); PG8_BAR;
            }
        }
        if constexpr (ALIGN_EPI) { if (wr == 0) PG8_BAR; }
        if constexpr (!Epi::AFTER_DRAIN) { if constexpr (Epi::ROW_RSTD_LDS) E(acc, cur, wr, wc, fr, fq, ui); else E(acc, cur, wr, wc, fr, fq); S.done(cur); }
        if (!has_next) break;
#pragma unroll
        for (int a = 0; a < 2; ++a)
#pragma unroll
            for (int b = 0; b < 2; ++b)
#pragma unroll
                for (int m = 0; m < 4; ++m)
#pragma unroll
                    for (int n = 0; n < 2; ++n) acc[a][b][m][n] = (f32x4){0.f, 0.f, 0.f, 0.f};
        cur = nxt; cA = nA; cB = nB; ++ui;
        if constexpr (ALIGN_EPI) { if (wr == 1) PG8_BAR; }
    }
    PG8_WAIT_V(0);
    if constexpr (!ALIGN_EPI) { if (wr == 0) PG8_BAR; }
    PG8_BAR;
#undef PG8_SA
#undef PG8_SB
#undef PG8_STAGE
#undef PG8_LDA
#undef PG8_LDB
#undef PG8_MMA
#undef PG8_WAIT_V
#undef PG8_WAIT_L
#undef PG8_BAR
#undef PG8_SCHED
}
}

constexpr int NWAVES = 8;
constexpr int DEPTH = 4, BATCH = 2, SEQ = 8192, D = 2048, FF = 5632, NGU = 2 * FF, INC = 4608, ZW = 3584, NVT = 1024;
constexpr int M = BATCH * SEQ;
constexpr int GRID_W = 64, GRID_ROWS = SEQ / GRID_W;
constexpr float NA_SCALE = 0.08838834764831845f;

constexpr size_t MiB = 1u << 20;
constexpr size_t WS_CTL = 0, CTL_ZERO_BYTES = 1 * MiB;
constexpr size_t WS_SSQ = 1 * MiB;
constexpr size_t WS_SGW = 2 * MiB;
constexpr size_t WS_PWT = 3 * MiB;
constexpr size_t WS_W = 4 * MiB;
constexpr size_t LW_GU1 = 0, LW_D1 = 44 * MiB, LW_IN = 66 * MiB, LW_OUT = 84 * MiB, LW_GU2 = 92 * MiB, LW_D2 = 136 * MiB, LW_BYTES = 158 * MiB;
constexpr size_t WS_XB = WS_W + DEPTH * LW_BYTES;
constexpr size_t WS_ACT = WS_XB + 64 * MiB;
constexpr size_t WS_Z = WS_ACT + 176 * MiB;
constexpr size_t WS_VT = WS_Z + 112 * MiB;
constexpr size_t WS_MIX = WS_VT + 32 * MiB;
constexpr size_t WS_END = WS_MIX + 64 * MiB;
static_assert((size_t)NGU * D * 2 == 44 * MiB && (size_t)D * FF * 2 == 22 * MiB && (size_t)INC * D * 2 == 18 * MiB && (size_t)D * D * 2 == 8 * MiB, "weight sizes");
static_assert((size_t)M * FF * 2 == 176 * MiB && (size_t)M * ZW * 2 == 112 * MiB, "activation sizes");
constexpr int CW_BAR = 4096;

constexpr int RING_OFF = 0, RING_BYTES = 131072;
constexpr int SCR_OFF = RING_BYTES;
constexpr int LDSCTL_OFF = SCR_OFF + 16384, MISC_OFF = LDSCTL_OFF + 320;
constexpr int LDS_BYTES = LDSCTL_OFF + 1024;
static_assert(pg8::RRL_MAX * 1024 <= 16384 && LDS_BYTES <= 163840, "LDS scratch");
static_assert(MISC_OFF + 128 <= LDS_BYTES, "LDS map");
constexpr int VT_PITCH = 272;
constexpr int RPB_OFF = 98304;

#define GAS __attribute__((address_space(1)))
#define LAS __attribute__((address_space(3)))
typedef unsigned short bf16;
typedef unsigned v4u __attribute__((ext_vector_type(4)));
typedef unsigned v2u __attribute__((ext_vector_type(2)));
typedef float f32x4 __attribute__((ext_vector_type(4)));
typedef float f32x2 __attribute__((ext_vector_type(2)));
typedef short bf16x8 __attribute__((ext_vector_type(8)));
typedef GAS unsigned gu32;
#define RLX_AGENT __ATOMIC_RELAXED, __HIP_MEMORY_SCOPE_AGENT
#define LDS_WAIT() asm volatile("s_waitcnt lgkmcnt(0)" ::: "memory")
#define VM_WAIT() asm volatile("s_waitcnt vmcnt(0)" ::: "memory")
__device__ __forceinline__ unsigned f2bf(float f) { unsigned u = __builtin_bit_cast(unsigned, f); return (u + 0x7fffu + ((u >> 16) & 1u)) >> 16; }
__device__ __forceinline__ unsigned pk2(float lo, float hi) { return f2bf(lo) | (f2bf(hi) << 16); }
__device__ __forceinline__ float bf_lo(unsigned w) { return __builtin_bit_cast(float, w << 16); }
__device__ __forceinline__ float bf_hi(unsigned w) { return __builtin_bit_cast(float, w & 0xffff0000u); }

#define XB_TMO      128
#define XB_XCNT(j)  (256  + 64 * (j))
#define XB_XSUB(j)  (1280 + 64 * (j))
#define XB_XGEN(j)  (2304 + 64 * (j))
#define XB_TOP      3328
#define XB_TOPGEN   3392
#define XCD_BAR_WORDS 3456
#define XB_SPIN_CAP (1u << 18)

typedef GAS unsigned* xbp;
__device__ __forceinline__ unsigned xb_ld(xbp p)              { return __hip_atomic_load(p, __ATOMIC_RELAXED, __HIP_MEMORY_SCOPE_AGENT); }
__device__ __forceinline__ unsigned xb_add(xbp p, unsigned v) { return __hip_atomic_fetch_add(p, v, __ATOMIC_RELAXED, __HIP_MEMORY_SCOPE_AGENT); }
__device__ __forceinline__ unsigned xb_xcc_id() { return (unsigned)__builtin_amdgcn_s_getreg((3 << 11) | 20) & 0xFu; }
#define XB_SPIN(cond, bar) do { unsigned _sp = 0; while (cond) { __builtin_amdgcn_s_sleep(1); \
    if ((++_sp & 255u) == 0u) { if (xb_ld(&(bar)[XB_TMO])) break; if (_sp > XB_SPIN_CAP) { xb_add(&(bar)[XB_TMO], 1u); break; } } } } while (0)

struct XcdBarrier {
    xbp bar; unsigned x;
    volatile LAS unsigned* st;
    bool t0;
};
__device__ __forceinline__ XcdBarrier xcd_barrier_post(xbp bar, volatile LAS unsigned* st) {
    XcdBarrier b; b.bar = bar; b.x = xb_xcc_id(); b.st = st; b.t0 = (threadIdx.x == 0);
    if (b.t0) (void)xb_add(&bar[XB_XCNT(b.x)], 1u);
    return b;
}
__device__ __forceinline__ void xcd_barrier_complete(xbp bar, unsigned x, unsigned& nloc, unsigned& nx) {
    const unsigned G = gridDim.x * gridDim.y * gridDim.z;
    unsigned sum, cnt, mine, sp = 0u;
    for (;;) {
        sum = 0u; cnt = 0u; mine = 0u;
#pragma unroll
        for (unsigned j = 0; j < 16; ++j) { const unsigned c = xb_ld(&bar[XB_XCNT(j)]); sum += c; cnt += (c > 0u) ? 1u : 0u; mine = (j == x) ? c : mine; }
        if (sum == G) break;
        __builtin_amdgcn_s_sleep(1);
        if ((++sp & 255u) == 0u) { if (xb_ld(&bar[XB_TMO])) break; if (sp > XB_SPIN_CAP) { xb_add(&bar[XB_TMO], 1u); break; } }
    }
    nloc = mine > 0u ? mine : 1u; nx = cnt > 0u ? cnt : 1u;
}
__device__ __forceinline__ void xcd_barrier(const XcdBarrier& b) {
    asm volatile("s_waitcnt vmcnt(0)" ::: "memory");
    __syncthreads();
    if (b.t0) {
        xbp bar = b.bar;
        __builtin_amdgcn_s_waitcnt(0);
        unsigned nloc = b.st[0], nx = b.st[1];
        if (nloc == 0u) { xcd_barrier_complete(bar, b.x, nloc, nx); b.st[0] = nloc; b.st[1] = nx; }
        const unsigned old = xb_add(&bar[XB_XSUB(b.x)], 1u);
        const unsigned gen = old / nloc;
        if (old + 1u == (gen + 1u) * nloc) {
            __builtin_amdgcn_fence(__ATOMIC_RELEASE, "agent");
            asm volatile("s_waitcnt vmcnt(0)" ::: "memory");
            const unsigned og = xb_add(&bar[XB_TOP], 1u);
            const unsigned tg = og / nx;
            if (og + 1u == (tg + 1u) * nx) xb_add(&bar[XB_TOPGEN], 1u);
            else XB_SPIN(xb_ld(&bar[XB_TOPGEN]) == tg, bar);
            __builtin_amdgcn_fence(__ATOMIC_ACQUIRE, "agent");
            xb_add(&bar[XB_XGEN(b.x)], 1u);
            asm volatile("s_waitcnt vmcnt(0)" ::: "memory");
        } else {
            XB_SPIN(xb_ld(&bar[XB_XGEN(b.x)]) == gen, bar);
            __builtin_amdgcn_fence(__ATOMIC_ACQUIRE, "agent");
            asm volatile("s_waitcnt vmcnt(0)" ::: "memory");
        }
    }
    __syncthreads();
}

typedef GAS unsigned char* gptr;
typedef const GAS float* gcf32;
typedef GAS bf16* gbf;
typedef const GAS bf16* gcbf;
struct Args { const float* in[19]; float* out; unsigned char* ws; };
typedef const __attribute__((address_space(4))) Args* kargp;
struct Frame {
    LAS unsigned char* lds;
    int tid, lane, wave;
    int G, bid;
    GAS float* X;
    gptr ws;
    kargp ap;
    __device__ __forceinline__ gbf XB() const { return (gbf)(ws + WS_XB); }
    __device__ __forceinline__ gbf ACT() const { return (gbf)(ws + WS_ACT); }
    __device__ __forceinline__ gbf Z() const { return (gbf)(ws + WS_Z); }
    __device__ __forceinline__ gbf VT() const { return (gbf)(ws + WS_VT); }
    __device__ __forceinline__ gbf MIX() const { return (gbf)(ws + WS_MIX); }
    __device__ __forceinline__ gbf SGW() const { return (gbf)(ws + WS_SGW); }
    __device__ __forceinline__ gbf PWT() const { return (gbf)(ws + WS_PWT); }
    __device__ __forceinline__ GAS float* SSQ() const { return (GAS float*)(ws + WS_SSQ); }
};
#define ARG_IN(k) ((gcf32)F.ap->in[k])

__device__ __forceinline__ float wave_sum(float v) {
#pragma unroll
    for (int o = 1; o < 64; o <<= 1) v += __shfl_xor(v, o);
    return v;
}

__device__ __forceinline__ void p0_transpose_item(gcf32 W, int K, int N, gbf WT, int rowmode, gcf32 gain, LAS float* scr, int item, int lane) {
    const int nblk = N / 32, kb = item / nblk, nb = item % nblk, k0 = 64 * kb, n0 = 32 * nb;
    int rowbase = n0;
    if (rowmode == 1) rowbase = 256 * (n0 >> 7) + (n0 & 127);
    if (rowmode == 2) rowbase = 256 * (n0 >> 7) + 128 + (n0 & 127);
#pragma unroll 8
    for (int i = 0; i < 32; ++i) { const int kk = 2 * i + (lane >> 5); float v = W[(size_t)(k0 + kk) * N + n0 + (lane & 31)]; if (gain) v *= gain[k0 + kk]; scr[kk * 33 + (lane & 31)] = v; }
    LDS_WAIT(); asm volatile("" ::: "memory");
    const int c = lane & 7;
#pragma unroll
    for (int j = 0; j < 4; ++j) { const int n = (lane >> 3) + 8 * j; const LAS float* s = scr + (8 * c) * 33 + n;
        v4u o; o.x = pk2(s[0 * 33], s[1 * 33]); o.y = pk2(s[2 * 33], s[3 * 33]); o.z = pk2(s[4 * 33], s[5 * 33]); o.w = pk2(s[6 * 33], s[7 * 33]);
        *(GAS v4u*)(WT + (size_t)(rowbase + n) * K + k0 + 8 * c) = o; }
    LDS_WAIT(); asm volatile("" ::: "memory");
}

struct P0Tile { gcf32 W; gcf32 gain; gbf WT; int K, N, rowmode, k0, n0, has_gain; };
constexpr int P0_SLOT = 8192 + 256;
static_assert(NWAVES * 2 * P0_SLOT <= LDSCTL_OFF, "prologue slots fit below the LDS control words");
constexpr int P0_T_G = (D / 64) * (FF / 256), P0_T_D = (FF / 64) * (D / 256), P0_T_IN = (D / 64) * (INC / 256), P0_T_OUT = (D / 64) * (D / 256);
constexpr int P0_PER_LAYER = 4 * P0_T_G + 2 * P0_T_D + P0_T_IN + P0_T_OUT, P0_TOTAL = DEPTH * P0_PER_LAYER;
__device__ __forceinline__ void p0_tile_decode(const Frame& F, int T, P0Tile& t) {
    constexpr int T_G = P0_T_G, T_D = P0_T_D, T_IN = P0_T_IN, T_OUT = P0_T_OUT;
    const int l = T / P0_PER_LAYER; int r = T % P0_PER_LAYER;
    gptr wl = F.ws + WS_W + (size_t)l * LW_BYTES; const size_t oG = (size_t)l * D * FF;
    int nblk;
    if (r < T_G)                { t.W = ARG_IN(2) + oG;  t.gain = ARG_IN(1) + l * D;  t.WT = (gbf)(wl + LW_GU1); t.K = D;  t.N = FF;  t.rowmode = 1; }
    else if ((r -= T_G) < T_G)  { t.W = ARG_IN(3) + oG;  t.gain = ARG_IN(1) + l * D;  t.WT = (gbf)(wl + LW_GU1); t.K = D;  t.N = FF;  t.rowmode = 2; }
    else if ((r -= T_G) < T_D)  { t.W = ARG_IN(4) + oG;  t.gain = ARG_IN(4) + oG;     t.WT = (gbf)(wl + LW_D1);  t.K = FF; t.N = D;   t.rowmode = 0; }
    else if ((r -= T_D) < T_IN) { t.W = ARG_IN(6) + (size_t)l * D * INC; t.gain = ARG_IN(5) + l * D; t.WT = (gbf)(wl + LW_IN); t.K = D; t.N = INC; t.rowmode = 0; }
    else if ((r -= T_IN) < T_OUT) { t.W = ARG_IN(13) + (size_t)l * D * D; t.gain = ARG_IN(13);  t.WT = (gbf)(wl + LW_OUT); t.K = D;  t.N = D;   t.rowmode = 0; }
    else if ((r -= T_OUT) < T_G) { t.W = ARG_IN(15) + oG; t.gain = ARG_IN(14) + l * D; t.WT = (gbf)(wl + LW_GU2); t.K = D;  t.N = FF;  t.rowmode = 1; }
    else if ((r -= T_G) < T_G)  { t.W = ARG_IN(16) + oG; t.gain = ARG_IN(14) + l * D; t.WT = (gbf)(wl + LW_GU2); t.K = D;  t.N = FF;  t.rowmode = 2; }
    else { r -= T_G;              t.W = ARG_IN(17) + oG; t.gain = ARG_IN(17) + oG;    t.WT = (gbf)(wl + LW_D2);  t.K = FF; t.N = D;   t.rowmode = 0; }
    t.has_gain = (t.rowmode != 0) || (t.N == INC);
    nblk = t.N / 256; t.k0 = 64 * (r / nblk); t.n0 = 256 * (r % nblk);
}
__device__ __forceinline__ void p0_strip_issue(const P0Tile& t, int w, int lane, LAS unsigned char* slot) {
    gcf32 src = t.W + (size_t)(t.k0 + (lane >> 3)) * t.N + t.n0 + 32 * w;
#pragma unroll
    for (int j = 0; j < 8; ++j) __builtin_amdgcn_global_load_lds((const GAS unsigned*)(src + (size_t)(8 * j) * t.N + 4 * ((lane & 7) ^ j)), (LAS unsigned*)(slot + j * 1024), 16, 0, 0);
    __builtin_amdgcn_global_load_lds((const GAS unsigned*)(t.gain + t.k0 + lane), (LAS unsigned*)(slot + 8192), 4, 0, 0);
}
__device__ __forceinline__ void p0_strip_finish(const P0Tile& t, int w, int lane, const LAS unsigned char* slot) {
    const int k8 = lane & 7, nl = lane >> 3;
    float g[8];
    { const f32x4 ga = *(const LAS f32x4*)(slot + 8192 + 32 * k8), gb = *(const LAS f32x4*)(slot + 8192 + 32 * k8 + 16);
      g[0] = ga.x; g[1] = ga.y; g[2] = ga.z; g[3] = ga.w; g[4] = gb.x; g[5] = gb.y; g[6] = gb.z; g[7] = gb.w;
#pragma unroll
      for (int i = 0; i < 8; ++i) g[i] = t.has_gain ? g[i] : 1.f; }
#pragma unroll
    for (int q = 0; q < 4; ++q) { const int n = nl + 8 * q;
        const LAS float* s = (const LAS float*)slot + (8 * k8) * 32 + 4 * ((n >> 2) ^ k8) + (n & 3);
        v4u o; o.x = pg8::cvt_pk_bf16(s[0] * g[0], s[32] * g[1]); o.y = pg8::cvt_pk_bf16(s[64] * g[2], s[96] * g[3]);
        o.z = pg8::cvt_pk_bf16(s[128] * g[4], s[160] * g[5]); o.w = pg8::cvt_pk_bf16(s[192] * g[6], s[224] * g[7]);
        const int nn = t.n0 + 32 * w + n; int row = nn;
        if (t.rowmode == 1) row = 256 * (nn >> 7) + (nn & 127);
        if (t.rowmode == 2) row = 256 * (nn >> 7) + 128 + (nn & 127);
        *(GAS v4u*)(t.WT + (size_t)row * t.K + t.k0 + 8 * k8) = o; }
}

__device__ __forceinline__ void p0_convert_tiles(Frame& F, int first, int stride, int nT) {
    LAS unsigned char* slot0 = F.lds + RING_OFF + F.wave * (2 * P0_SLOT); LAS unsigned char* slot1 = slot0 + P0_SLOT;
    P0Tile ta, tb; const int w = F.wave;
    p0_tile_decode(F, first, ta); p0_strip_issue(ta, w, F.lane, slot0);
    for (int i = 0; i < nT; i += 2) {
        p0_tile_decode(F, first + min(i + 1, nT - 1) * stride, tb); p0_strip_issue(tb, w, F.lane, slot1);
        asm volatile("s_waitcnt vmcnt(9)" ::: "memory");
        p0_strip_finish(ta, w, F.lane, slot0);
        if (i + 1 >= nT) break;
        p0_tile_decode(F, first + min(i + 2, nT - 1) * stride, ta); p0_strip_issue(ta, w, F.lane, slot0);
        asm volatile("s_waitcnt vmcnt(9)" ::: "memory");
        p0_strip_finish(tb, w, F.lane, slot1);
    }
    VM_WAIT(); LDS_WAIT(); __builtin_amdgcn_s_barrier();
}
constexpr int P0_LATE_GRID = 256, P0_LATE_PER_WG = 10, P0_LATE_SLOTS = 3, P0_LATE_PER_SLOT = 128 * P0_LATE_PER_WG, P0_LATE = P0_LATE_SLOTS * P0_LATE_PER_SLOT;
static_assert(P0_LATE <= P0_PER_LAYER, "late tiles all belong to the last layer");
__device__ __forceinline__ void p0_late_slot(Frame& F, int l) {
    if (F.G != P0_LATE_GRID || l >= P0_LATE_SLOTS || F.bid < 128) return;
    p0_convert_tiles(F, P0_TOTAL - P0_LATE + l * P0_LATE_PER_SLOT + (F.bid - 128), 128, P0_LATE_PER_WG);
}

__device__ __forceinline__ void p0_prologue(Frame& F) {
    { const int early = (F.G == P0_LATE_GRID) ? P0_TOTAL - P0_LATE : P0_TOTAL; const int c = F.bid, G = F.G;
      if (c < early) p0_convert_tiles(F, c, G, (early - c + G - 1) / G); }
    LAS float* scr = (LAS float*)(F.lds + RING_OFF + F.wave * 16384);
    const int gw = F.bid * NWAVES + F.wave, NGW = F.G * NWAVES;
    for (int it = gw; it < DEPTH * 4 * 8; it += NGW) { const int lg = it >> 3, sub = it & 7;
        p0_transpose_item(ARG_IN(10) + (size_t)lg * 16384, 128, 128, F.PWT() + (size_t)lg * 16384, 0, nullptr, scr, sub, F.lane); }
    { gcf32 sw = ARG_IN(8); const int gt = F.bid * (NWAVES * 64) + F.tid, NT = F.G * NWAVES * 64;
      for (int i = gt; i < DEPTH * 4 * 128 * 128 / 4; i += NT) { const f32x4 v = *(const GAS f32x4*)(sw + (size_t)i * 4); v2u o; o.x = pk2(v.x, v.y); o.y = pk2(v.z, v.w); *(GAS v2u*)(F.SGW() + (size_t)i * 4) = o; } }
    gcf32 x = ARG_IN(0);
    for (int m = gw; m < M; m += NGW) {
        const GAS f32x4* xr = (const GAS f32x4*)(x + (size_t)m * D) + F.lane; GAS v2u* brow = (GAS v2u*)(F.XB() + (size_t)m * D) + F.lane;
        float s = 0.f;
#pragma unroll
        for (int j = 0; j < 8; ++j) { const f32x4 v = xr[64 * j]; s += (v.x * v.x + v.y * v.y) + (v.z * v.z + v.w * v.w); v2u o; o.x = pk2(v.x, v.y); o.y = pk2(v.z, v.w); brow[64 * j] = o; }
        s = wave_sum(s);
        if (F.lane < 8) F.SSQ()[(size_t)m * 8 + F.lane] = (F.lane == 0) ? s : 0.f;
    }
}

constexpr int VT_IMG = 128 * VT_PITCH;
template <int NU> __device__ __forceinline__ void mix_gating_units(Frame& F, int l, int u0, int ustride) {
    const int h = u0 & 3;
    LAS unsigned char* vT = F.lds + RING_OFF;
    {
        const int pos = F.tid >> 2, cq = F.tid & 3;
        v4u w[NU][4];
#pragma unroll
        for (int e = 0; e < NU; ++e) { gcbf zv = F.Z() + (size_t)(((u0 + e * ustride) >> 2) * 128 + pos) * ZW + 512 + h * 128 + cq * 32;
#pragma unroll
            for (int i = 0; i < 4; ++i) w[e][i] = *(const GAS v4u*)(zv + 8 * i); }
        gcf32 gn = ARG_IN(7) + l * 512 + h * 128 + cq * 32;
        f32x4 gv[8];
#pragma unroll
        for (int c4 = 0; c4 < 8; ++c4) gv[c4] = *(const GAS f32x4*)(gn + 4 * c4);
#pragma unroll
        for (int e = 0; e < NU; ++e) {
            float v[32];
#pragma unroll
            for (int i = 0; i < 4; ++i)
#pragma unroll
                for (int k = 0; k < 4; ++k) { const unsigned ww = w[e][i][k]; const f32x2 gl = pg8::gelu_pk((f32x2){bf_lo(ww), bf_hi(ww)}); v[8 * i + 2 * k] = gl.x; v[8 * i + 2 * k + 1] = gl.y; }
            float ss = 0.f;
#pragma unroll
            for (int c = 0; c < 32; ++c) ss += v[c] * v[c];
            ss += __shfl_xor(ss, 1); ss += __shfl_xor(ss, 2);
            const float rstd = __builtin_amdgcn_rsqf(ss * (1.0f / 128.0f) + pg8::RMS_EPS);
#pragma unroll
            for (int c4 = 0; c4 < 8; ++c4)
#pragma unroll
                for (int k = 0; k < 4; ++k) { const int c = 4 * c4 + k; *(LAS unsigned short*)(vT + e * VT_IMG + (cq * 32 + c) * VT_PITCH + pos * 2) = (unsigned short)f2bf(v[c] * rstd * gv[c4][k]); }
        }
    }
    __syncthreads();
    {
        const int fr = F.lane & 15, fq = F.lane >> 4, p = 16 * F.wave + fr;
        gcbf wsrow = F.SGW() + ((size_t)(l * 4 + h) * 128 + p) * 128 + 8 * fq;
        bf16x8 bfrag[4];
#pragma unroll
        for (int ks = 0; ks < 4; ++ks) bfrag[ks] = *(const GAS bf16x8*)(wsrow + 32 * ks);
        const float bias = ARG_IN(9)[(l * 4 + h) * 128 + p];
        v2u zz[NU][8];
#pragma unroll
        for (int e = 0; e < NU; ++e) { gcbf zu = F.Z() + (size_t)(((u0 + e * ustride) >> 2) * 128 + p) * ZW + h * 128 + 4 * fq;
#pragma unroll
            for (int dt = 0; dt < 8; ++dt) zz[e][dt] = *(const GAS v2u*)(zu + 16 * dt); }
#pragma unroll
        for (int e = 0; e < NU; ++e) {
            f32x4 acc[8];
#pragma unroll
            for (int dt = 0; dt < 8; ++dt) acc[dt] = (f32x4){0.f, 0.f, 0.f, 0.f};
#pragma unroll
            for (int ks = 0; ks < 4; ++ks)
#pragma unroll
                for (int dt = 0; dt < 8; ++dt) { const bf16x8 afrag = *(const LAS bf16x8*)(vT + e * VT_IMG + (16 * dt + fr) * VT_PITCH + 64 * ks + 16 * fq);
                    acc[dt] = __builtin_amdgcn_mfma_f32_16x16x32_bf16(afrag, bfrag[ks], acc[dt], 0, 0, 0); }
            gbf o = F.MIX() + (size_t)(((u0 + e * ustride) >> 2) * 128 + p) * D + h * 128 + 4 * fq;
#pragma unroll
            for (int dt = 0; dt < 8; ++dt) { const v2u z2 = zz[e][dt];
                const f32x2 a0 = pg8::gelu_pk((f32x2){bf_lo(z2.x), bf_hi(z2.x)}), a1 = pg8::gelu_pk((f32x2){bf_lo(z2.y), bf_hi(z2.y)});
                v2u wv; wv.x = pg8::cvt_pk_bf16(a0.x * (acc[dt][0] + bias), a0.y * (acc[dt][1] + bias)); wv.y = pg8::cvt_pk_bf16(a1.x * (acc[dt][2] + bias), a1.y * (acc[dt][3] + bias));
                *(GAS v2u*)(o + 16 * dt) = wv; }
        }
    }
    __syncthreads();
}

constexpr int PL_PITCH = 272, PL_IMG = 32 * PL_PITCH, PL_SLOT = 2 * PL_IMG;
static_assert(NWAVES * PL_SLOT <= LDSCTL_OFF, "pool slots fit below the LDS control words");
template <int g, int NUN> __device__ __forceinline__ void mix_pool_units(Frame& F, int l, int u0, int ustride) {
    constexpr int half = 1 << g;
    int lane = F.lane; asm volatile("" : "+v"(lane));
    const int fr = lane & 15, fq = lane >> 4;
    LAS unsigned char* slot = F.lds + RING_OFF + F.wave * PL_SLOT;
    gcbf pw = F.PWT() + (size_t)(l * 4 + g) * 16384 + 8 * fq;
    {
        v4u rv[NUN][8];
#pragma unroll
        for (int e = 0; e < NUN; ++e) { const int tok0 = ((u0 + e * ustride) >> 2) * 16, b = tok0 >> 13, s0 = tok0 & (SEQ - 1);
            gcbf zrow = F.Z() + (size_t)(b * SEQ) * ZW + 1024 + g * 128 + 8 * (lane & 15);
#pragma unroll
            for (int i = 0; i < 8; ++i) { const int pos = min(max(s0 - half + 4 * i + (lane >> 4), 0), SEQ - 1); rv[e][i] = *(const GAS v4u*)(zrow + (size_t)pos * ZW); } }
        __builtin_amdgcn_sched_barrier(0);
#pragma unroll
        for (int e = 0; e < NUN; ++e)
#pragma unroll
            for (int i = 0; i < 8; ++i) *(LAS v4u*)(slot + e * PL_IMG + (4 * i + (lane >> 4)) * PL_PITCH + (lane & 15) * 16) = rv[e][i];
    }
    bf16x8 afr[2][8];
    { gcbf pk = pw + (size_t)fr * 128; asm volatile("" : "+v"(pk));
#pragma unroll
      for (int dt = 0; dt < 8; ++dt) afr[0][dt] = *(const GAS bf16x8*)(pk + 2048 * dt); }
    f32x4 acc[NUN][8];
#pragma unroll
    for (int e = 0; e < NUN; ++e)
#pragma unroll
        for (int dt = 0; dt < 8; ++dt) acc[e][dt] = (f32x4){0.f, 0.f, 0.f, 0.f};
    LDS_WAIT(); asm volatile("" ::: "memory");
    const LAS unsigned char* rbase = slot + fr * PL_PITCH + fq * 16;
#pragma unroll
    for (int ks = 0; ks < 4; ++ks) {
        if (ks + 1 < 4) { gcbf pk = pw + (size_t)fr * 128 + 32 * (ks + 1); asm volatile("" : "+v"(pk));
#pragma unroll
            for (int dt = 0; dt < 8; ++dt) afr[(ks + 1) & 1][dt] = *(const GAS bf16x8*)(pk + 2048 * dt); }
#pragma unroll
        for (int e = 0; e < NUN; ++e) { const int tok0 = ((u0 + e * ustride) >> 2) * 16, s = (tok0 & (SEQ - 1)) + fr;
            const int lo = max(s - half, 0), hi = min(s + half, SEQ); const float inv_cnt = 1.0f / (float)(hi - lo);
            const LAS unsigned char* rb = rbase + e * PL_IMG + ks * 64;
            v4u wv[2 * half];
#pragma unroll
            for (int j = 0; j < 2 * half; ++j) wv[j] = *(const LAS v4u*)(rb + j * PL_PITCH);
            const v4u pc4 = *(const LAS v4u*)(rb + half * PL_PITCH);
            float sum[8];
#pragma unroll
            for (int k = 0; k < 8; ++k) sum[k] = 0.f;
#pragma unroll
            for (int j = 0; j < 2 * half; ++j) { const int pos = s + j - half; const float f = ((pos >= 0) && (pos < SEQ)) ? 1.0f : 0.0f; const v4u w = wv[j];
#pragma unroll
                for (int k = 0; k < 4; ++k) { sum[2 * k] += f * bf_lo(w[k]); sum[2 * k + 1] += f * bf_hi(w[k]); } }
            v4u dfr;
#pragma unroll
            for (int k = 0; k < 4; ++k) dfr[k] = pg8::cvt_pk_bf16(sum[2 * k] * inv_cnt - bf_lo(pc4[k]), sum[2 * k + 1] * inv_cnt - bf_hi(pc4[k]));
            const bf16x8 bfrag = __builtin_bit_cast(bf16x8, dfr);
#pragma unroll
            for (int dt = 0; dt < 8; ++dt) acc[e][dt] = __builtin_amdgcn_mfma_f32_16x16x32_bf16(afr[ks & 1][dt], bfrag, acc[e][dt], 0, 0, 0);
            __builtin_amdgcn_sched_barrier(0);
        }
    }
    gcf32 sc = ARG_IN(11) + l * 512 + g * 128 + 4 * fq;
    f32x4 sv[8];
#pragma unroll
    for (int dt = 0; dt < 8; ++dt) sv[dt] = *(const GAS f32x4*)(sc + 16 * dt);
#pragma unroll
    for (int e = 0; e < NUN; ++e) { const int tok = ((u0 + e * ustride) >> 2) * 16 + fr; gbf o = F.MIX() + (size_t)tok * D + 512 + g * 128 + 4 * fq;
#pragma unroll
        for (int dt = 0; dt < 8; ++dt) { v2u w; w.x = pg8::cvt_pk_bf16(acc[e][dt][0] * sv[dt].x, acc[e][dt][1] * sv[dt].y); w.y = pg8::cvt_pk_bf16(acc[e][dt][2] * sv[dt].z, acc[e][dt][3] * sv[dt].w);
            *(GAS v2u*)(o + 16 * dt) = w; } }
}
template <int NUN> __device__ __forceinline__ void mix_pool_dispatch(Frame& F, int l, int u0, int ustride) {
    const int g = u0 & 3;
    if (g == 0) mix_pool_units<0, NUN>(F, l, u0, ustride); else if (g == 1) mix_pool_units<1, NUN>(F, l, u0, ustride); else if (g == 2) mix_pool_units<2, NUN>(F, l, u0, ustride); else mix_pool_units<3, NUN>(F, l, u0, ustride);
}

__device__ __forceinline__ int na_fk(int key) { return (key & 3) | (((key >> 3) & 3) << 2); }
__device__ __forceinline__ void na_issue(gcbf zk, gcbf vth, int kr, int wave, int lane, LAS unsigned char* buf) {
#pragma unroll
    for (int e = 0; e < 2; ++e) { const int inst = 2 * wave + e;
        { const int key = 4 * inst + (lane >> 4), c = (lane & 15) ^ na_fk(key);
          __builtin_amdgcn_global_load_lds((const GAS unsigned*)(zk + (size_t)(kr * GRID_W + key) * ZW + 8 * c), (LAS unsigned*)(buf + inst * 1024), 16, 0, 0); }
        { const int d = 8 * inst + (lane >> 3), c = (lane & 7) ^ ((d >> 1) & 7);
          __builtin_amdgcn_global_load_lds((const GAS unsigned*)(vth + (size_t)d * SEQ + kr * GRID_W + 8 * c), (LAS unsigned*)(buf + 16384 + inst * 1024), 16, 0, 0); } }
}
__device__ __forceinline__ void mix_na_unit(Frame& F, int unit) {
    const int b = unit >> 8, h = (unit >> 5) & 7, rq = unit & 31;
    const int fr = F.lane & 15, fq = F.lane >> 4;
    const int r = 4 * rq + (F.wave >> 1), i0 = 2 * (F.wave & 1);
    const int sr = min(max(r - 4, 0), GRID_ROWS - 8);
    const int kr_lo = min(max(4 * rq - 4, 0), GRID_ROWS - 8), kr_hi = min(max(4 * rq - 1, 0), GRID_ROWS - 8) + 7, nsteps = kr_hi - kr_lo + 1;
    const LAS float* rpb = (const LAS float*)(F.lds + RPB_OFF) + h * (15 * 31);
    gcbf zk = F.Z() + (size_t)(b * SEQ) * ZW + 2560 + h * 128;
    gcbf vth = F.VT() + (size_t)(b * 1024 + h * 128) * SEQ;
    LAS unsigned char* nab = F.lds + RING_OFF;
    bf16x8 qf[2][4];
#pragma unroll
    for (int ii = 0; ii < 2; ++ii) { gcbf qp = F.Z() + (size_t)(b * SEQ + r * GRID_W + 16 * (i0 + ii) + fr) * ZW + 1536 + h * 128 + 8 * fq;
#pragma unroll
        for (int ks = 0; ks < 4; ++ks) qf[ii][ks] = *(const GAS bf16x8*)(qp + 32 * ks); }
    f32x4 oacc[2][8]; float mrun[2], lrun[2];
#pragma unroll
    for (int ii = 0; ii < 2; ++ii) { mrun[ii] = -1e30f; lrun[ii] = 0.f;
#pragma unroll
        for (int dt = 0; dt < 8; ++dt) oacc[ii][dt] = (f32x4){0.f, 0.f, 0.f, 0.f}; }
    __syncthreads();
    na_issue(zk, vth, kr_lo, F.wave, F.lane, nab);
    for (int t = 0; t < nsteps; ++t) {
        asm volatile("s_waitcnt vmcnt(0)" ::: "memory"); __builtin_amdgcn_s_barrier(); asm volatile("" ::: "memory");
        if (t + 1 < nsteps) na_issue(zk, vth, kr_lo + t + 1, F.wave, F.lane, nab + ((t + 1) & 1) * 32768);
        const int kr = kr_lo + t;
        if (kr >= sr && kr <= sr + 7) {
            const LAS unsigned char* kb = nab + (t & 1) * 32768; const LAS unsigned char* vb = kb + 16384;
            const LAS float* rrow = rpb + (kr - r + 7) * 31;
#pragma unroll
            for (int ii = 0; ii < 2; ++ii) {
                const int i = i0 + ii, qc = 16 * i + fr;
                const int cb = (i == 0) ? 0 : (i == 1) ? 8 : (i == 2) ? 24 : 32;
                const int cs = min(max(qc - 8, 0), GRID_W - 16);
                bf16x8 kf[2][4]; float bias[8];
#pragma unroll
                for (int hh = 0; hh < 2; ++hh) { const int kcl = cb + 8 * (fr >> 2) + (fr & 3) + 4 * hh, fk = na_fk(kcl);
#pragma unroll
                    for (int ks = 0; ks < 4; ++ks) kf[hh][ks] = *(const LAS bf16x8*)(kb + kcl * 256 + (((4 * ks + fq) ^ fk) << 4)); }
#pragma unroll
                for (int k = 0; k < 8; ++k) { const int kc = cb + 8 * fq + k; bias[k] = rrow[min(max(kc - qc + 15, 0), 30)]; }
                __builtin_amdgcn_sched_barrier(0);
#pragma unroll
                for (int k = 0; k < 8; ++k) asm volatile("" : "+v"(bias[k]));
                f32x4 sa[2];
#pragma unroll
                for (int hh = 0; hh < 2; ++hh) { f32x4 a = (f32x4){0.f, 0.f, 0.f, 0.f};
#pragma unroll
                    for (int ks = 0; ks < 4; ++ks) a = __builtin_amdgcn_mfma_f32_16x16x32_bf16(kf[hh][ks], qf[ii][ks], a, 0, 0, 0);
                    sa[hh] = a; }
                float sv[8]; float mt = -1e30f;
#pragma unroll
                for (int hh = 0; hh < 2; ++hh)
#pragma unroll
                    for (int j = 0; j < 4; ++j) { const int kc = cb + 8 * fq + 4 * hh + j; const bool ok = (kc >= cs) && (kc < cs + 16);
                        const float x = ok ? (sa[hh][j] * NA_SCALE + bias[4 * hh + j]) : -1e30f; sv[4 * hh + j] = x; mt = fmaxf(mt, x); }
                mt = fmaxf(mt, __shfl_xor(mt, 16)); mt = fmaxf(mt, __shfl_xor(mt, 32));
                const float mnew = fmaxf(mrun[ii], mt), alpha = __builtin_amdgcn_exp2f((mrun[ii] - mnew) * 1.44269504089f);
                mrun[ii] = mnew;
                float e[8], ps = 0.f;
#pragma unroll
                for (int k = 0; k < 8; ++k) { e[k] = __builtin_amdgcn_exp2f((sv[k] - mnew) * 1.44269504089f); ps += e[k]; }
                lrun[ii] = lrun[ii] * alpha + ps;
                v4u pw; pw.x = pg8::cvt_pk_bf16(e[0], e[1]); pw.y = pg8::cvt_pk_bf16(e[2], e[3]); pw.z = pg8::cvt_pk_bf16(e[4], e[5]); pw.w = pg8::cvt_pk_bf16(e[6], e[7]);
                const bf16x8 pf = __builtin_bit_cast(bf16x8, pw);
#pragma unroll
                for (int dh = 0; dh < 2; ++dh) { bf16x8 vf[4];
#pragma unroll
                    for (int dq = 0; dq < 4; ++dq) { const int d = 16 * (4 * dh + dq) + fr; vf[dq] = *(const LAS bf16x8*)(vb + d * 128 + ((((cb >> 3) + fq) ^ ((d >> 1) & 7)) << 4)); }
                    __builtin_amdgcn_sched_barrier(0);
#pragma unroll
                    for (int dq = 0; dq < 4; ++dq) oacc[ii][4 * dh + dq] = __builtin_amdgcn_mfma_f32_16x16x32_bf16(vf[dq], pf, oacc[ii][4 * dh + dq] * alpha, 0, 0, 0); }
            }
        }
    }
#pragma unroll
    for (int ii = 0; ii < 2; ++ii) { float l = lrun[ii]; l += __shfl_xor(l, 16); l += __shfl_xor(l, 32); const float inv = 1.0f / l;
        gbf op = F.MIX() + (size_t)(b * SEQ + r * GRID_W + 16 * (i0 + ii) + fr) * D + 1024 + h * 128 + 4 * fq;
#pragma unroll
        for (int dt = 0; dt < 8; ++dt) { const f32x4 o = oacc[ii][dt]; v2u w; w.x = pg8::cvt_pk_bf16(o[0] * inv, o[1] * inv); w.y = pg8::cvt_pk_bf16(o[2] * inv, o[3] * inv); *(GAS v2u*)(op + 16 * dt) = w; } }
}

__device__ __forceinline__ void mix_phase(Frame& F, int l, int st) {
    const int odd = F.bid & 1;
    {
        if ((st == 0) == (odd != 0)) {
            { gcf32 rp = ARG_IN(12) + (size_t)l * (8 * 15 * 31); LAS float* t = (LAS float*)(F.lds + RPB_OFF);
              for (int i = F.tid; i < 8 * 15 * 31; i += NWAVES * 64) t[i] = rp[i]; }
            for (int u = F.bid; u < BATCH * 8 * (GRID_ROWS / 4); u += F.G) mix_na_unit(F, u);
            __syncthreads();
        } else {
            {
                constexpr int NUNITS = (M / 128) * 4;
                if ((F.G & 3) == 0) { for (int u = F.bid; u < NUNITS; u += 2 * F.G) { if (u + F.G < NUNITS) mix_gating_units<2>(F, l, u, F.G); else mix_gating_units<1>(F, l, u, 0); } }
                else for (int u = F.bid; u < NUNITS; u += F.G) mix_gating_units<1>(F, l, u, 0);
            }
            const int gw = F.bid * NWAVES + F.wave, NGW = F.G * NWAVES;
            {
                constexpr int NUNITS = (M / 16) * 4;
                if ((NGW & 3) == 0) { for (int u = gw; u < NUNITS; u += 2 * NGW) { if (u + NGW < NUNITS) mix_pool_dispatch<2>(F, l, u, NGW); else mix_pool_dispatch<1>(F, l, u, 0); } }
                else for (int u = gw; u < NUNITS; u += NGW) mix_pool_dispatch<1>(F, l, u, 0);
            }
            __syncthreads();
        }
    }
}

#define PHASE_FRAME(F) Frame F; { unsigned z_ = 0u; asm volatile("" : "+s"(z_)); int t_ = (int)__builtin_amdgcn_mbcnt_hi(~0u, __builtin_amdgcn_mbcnt_lo(~0u, z_)) + 64 * wave_id_; asm volatile("" : "+v"(t_)); kargp a_ = (kargp)__builtin_amdgcn_kernarg_segment_ptr(); asm volatile("" : "+s"(a_)); \
    F.lds = (LAS unsigned char*)lds; F.tid = t_; F.lane = t_ & 63; F.wave = __builtin_amdgcn_readfirstlane(t_ >> 6); { int g_ = (int)gridDim.x, c_ = (int)blockIdx.x; asm volatile("" : "+s"(g_), "+s"(c_)); F.G = g_; F.bid = c_; } F.ap = a_; F.X = (GAS float*)a_->out; F.ws = (gptr)a_->ws; }
__global__ void __launch_bounds__(NWAVES * 64, 2) mega_fwd(Args args) {
    extern __shared__ __attribute__((aligned(16))) unsigned char lds[];
    const int wave_id_ = __builtin_amdgcn_readfirstlane((int)threadIdx.x >> 6);
    for (int u = threadIdx.x; u < (LDS_BYTES - LDSCTL_OFF) / 4; u += NWAVES * 64) ((LAS unsigned*)((LAS unsigned char*)lds + LDSCTL_OFF))[u] = 0u;
    __syncthreads();
    (void)xcd_barrier_post((xbp)(args.ws + WS_CTL) + CW_BAR, (volatile LAS unsigned*)((LAS unsigned char*)lds + MISC_OFF) + 8);
#define GRID_BAR() do { kargp a_ = (kargp)__builtin_amdgcn_kernarg_segment_ptr(); asm volatile("" : "+s"(a_)); XcdBarrier b_; b_.bar = (xbp)((gptr)a_->ws + WS_CTL) + CW_BAR; b_.x = xb_xcc_id(); \
        b_.st = (volatile LAS unsigned*)((LAS unsigned char*)lds + MISC_OFF) + 8; unsigned z_ = 0u; asm volatile("" : "+s"(z_)); b_.t0 = (wave_id_ == 0) && (__builtin_amdgcn_mbcnt_hi(~0u, __builtin_amdgcn_mbcnt_lo(~0u, z_)) == 0u); xcd_barrier(b_); } while (0)

    { PHASE_FRAME(F); p0_prologue(F); }
    GRID_BAR();

    for (int s = 0; s < 2 * DEPTH; ++s) {
        const int l = s >> 1, j = s & 1;
        {
            PHASE_FRAME(F); gptr wl = F.ws + WS_W + (size_t)l * LW_BYTES;
            pg8::Gemm g{F.XB(), (gcbf)(wl + (j ? LW_GU2 : LW_GU1)), M, NGU, D}; pg8::StaticOrder S; S.init(M, NGU, F.G, F.bid, 8);
            pg8::EpiGateUp E{F.ACT(), FF, pg8::RowRstdLds{F.SSQ(), (LAS float*)(F.lds + SCR_OFF)}};
            pg8::gemm_phase<pg8::EpiGateUp, pg8::StaticOrder, true, true>(F.lds + RING_OFF, g, S, E, F.tid);
        }
        GRID_BAR();
        {
            PHASE_FRAME(F); gptr wl = F.ws + WS_W + (size_t)l * LW_BYTES;
            pg8::Gemm g{F.ACT(), (gcbf)(wl + (j ? LW_D2 : LW_D1)), M, D, FF}; pg8::StaticOrder S; S.init(M, D, F.G, F.bid);
            pg8::EpiResid E{(GAS float*)nullptr, F.XB(), F.SSQ(), 0.5f, (LAS float*)(F.lds + SCR_OFF), F.tid};
            pg8::gemm_phase<pg8::EpiResid, pg8::StaticOrder, true, true, true>(F.lds + RING_OFF, g, S, E, F.tid);
        }
        GRID_BAR();
        if (j == 0) {
            {
                PHASE_FRAME(F); gptr wl = F.ws + WS_W + (size_t)l * LW_BYTES;
                pg8::Gemm g{F.XB(), (gcbf)(wl + LW_IN), M, ZW, D}; pg8::StaticOrder S; S.init(M, ZW, F.G, F.bid);
                pg8::EpiZ E{F.Z(), ZW, pg8::RowRstdLds{F.SSQ(), (LAS float*)(F.lds + SCR_OFF)}};
                pg8::gemm_phase<pg8::EpiZ, pg8::StaticOrder, true, true>(F.lds + RING_OFF, g, S, E, F.tid);
            }
            {
                PHASE_FRAME(F); gptr wl = F.ws + WS_W + (size_t)l * LW_BYTES;
                pg8::Gemm g{(gcbf)(wl + LW_IN) + (size_t)ZW * D, F.XB(), NVT, M, D}; pg8::StaticOrder S; S.init(NVT, M, F.G, F.bid);
                pg8::EpiVT E{F.VT(), F.SSQ()};
                pg8::gemm_phase<pg8::EpiVT, pg8::StaticOrder, true, true>(F.lds + RING_OFF, g, S, E, F.tid);
            }
            { PHASE_FRAME(F); p0_late_slot(F, l); }
            GRID_BAR();
#pragma nounroll
            for (int st = 0; st < 2; ++st) { int st_ = st; asm volatile("" : "+s"(st_)); PHASE_FRAME(F); mix_phase(F, l, st_); }
            GRID_BAR();
            {
                PHASE_FRAME(F); gptr wl = F.ws + WS_W + (size_t)l * LW_BYTES;
                pg8::Gemm g{F.MIX(), (gcbf)(wl + LW_OUT), M, D, D}; pg8::StaticOrder S; S.init(M, D, F.G, F.bid);
                pg8::EpiResid E{(GAS float*)nullptr, F.XB(), F.SSQ(), 1.0f, (LAS float*)(F.lds + SCR_OFF), F.tid};
                pg8::gemm_phase<pg8::EpiResid, pg8::StaticOrder, true, true>(F.lds + RING_OFF, g, S, E, F.tid);
            }
            GRID_BAR();
        }
    }
    {
        PHASE_FRAME(F);
        const int gw = F.bid * NWAVES + F.wave, NGW = F.G * NWAVES;
        const GAS f32x4* gp = (const GAS f32x4*)ARG_IN(18) + 2 * F.lane;
        f32x4 gv[4][2];
#pragma unroll
        for (int jj = 0; jj < 4; ++jj) { gv[jj][0] = gp[128 * jj]; gv[jj][1] = gp[128 * jj + 1]; }
        for (int m = gw; m < M; m += NGW) { const float rs = pg8::row_rstd(F.SSQ(), m);
            const GAS pg8::u32x4* xr = (const GAS pg8::u32x4*)(F.XB() + (size_t)m * D) + F.lane; GAS f32x4* orow = (GAS f32x4*)(F.X + (size_t)m * D) + 2 * F.lane;
            pg8::u32x4 xv[4];
#pragma unroll
            for (int jj = 0; jj < 4; ++jj) xv[jj] = xr[64 * jj];
#pragma unroll
            for (int jj = 0; jj < 4; ++jj) { const pg8::u32x4 x = xv[jj]; f32x4 y0, y1;
                y0[0] = __builtin_bit_cast(float, x.x << 16); y0[1] = __builtin_bit_cast(float, x.x & 0xffff0000u); y0[2] = __builtin_bit_cast(float, x.y << 16); y0[3] = __builtin_bit_cast(float, x.y & 0xffff0000u);
                y1[0] = __builtin_bit_cast(float, x.z << 16); y1[1] = __builtin_bit_cast(float, x.z & 0xffff0000u); y1[2] = __builtin_bit_cast(float, x.w << 16); y1[3] = __builtin_bit_cast(float, x.w & 0xffff0000u);
                orow[128 * jj] = y0 * rs * gv[jj][0]; orow[128 * jj + 1] = y1 * rs * gv[jj][1]; } }
    }
}

extern "C" void kernel_launch(void* const* d_in, const int* in_sizes, int n_in, void* d_out, int out_size, void* d_ws, size_t ws_size, hipStream_t stream) {
    static int grid = 0;
    if (grid == 0) {
        if (n_in != 19 || in_sizes[0] != M * D || out_size != M * D || ws_size < WS_END) { fprintf(stderr, "kernel_launch: unexpected shapes: n_in %d in0 %d out %d ws %zu (need %zu)\n", n_in, n_in > 0 ? in_sizes[0] : -1, out_size, ws_size, (size_t)WS_END); grid = -1; return; }
        int dev = 0, cus = 0, per_cu = 0;
        if (hipGetDevice(&dev) != hipSuccess || hipDeviceGetAttribute(&cus, hipDeviceAttributeMultiprocessorCount, dev) != hipSuccess) { fprintf(stderr, "kernel_launch: device query failed\n"); grid = -1; return; }
        if (hipFuncSetAttribute((const void*)mega_fwd, hipFuncAttributeMaxDynamicSharedMemorySize, LDS_BYTES) != hipSuccess) { fprintf(stderr, "kernel_launch: hipFuncSetAttribute failed\n"); grid = -1; return; }
        if (hipOccupancyMaxActiveBlocksPerMultiprocessor(&per_cu, (const void*)mega_fwd, NWAVES * 64, LDS_BYTES) != hipSuccess || per_cu < 1)
            fprintf(stderr, "kernel_launch: note: occupancy query reports %d workgroups per CU\n", per_cu);
        (void)hipGetLastError();
        grid = cus;
    }
    if (grid < 0) return;
    if (hipMemsetAsync((char*)d_ws + WS_CTL, 0, CTL_ZERO_BYTES, stream) != hipSuccess) { fprintf(stderr, "kernel_launch: memset failed\n"); return; }
    Args a{};
    for (int i = 0; i < 19; ++i) a.in[i] = (const float*)d_in[i];
    a.out = (float*)d_out; a.ws = (unsigned char*)d_ws;
    hipLaunchKernelGGL(mega_fwd, dim3(grid), dim3(NWAVES * 64), LDS_BYTES, stream, a);
    const hipError_t le = hipPeekAtLastError();
    if (le != hipSuccess) fprintf(stderr, "kernel_launch: launch failed: %s\n", hipGetErrorName(le));
}
```

```cpp
#include <hip/hip_runtime.h>
#include <cstdio>
#include <cstdint>

namespace pg8 {
#define PG8_LAS __attribute__((address_space(3)))
#define PG8_GAS __attribute__((address_space(1)))
typedef unsigned short bf16_t;
typedef short bf16x8 __attribute__((ext_vector_type(8)));
typedef float f32x4 __attribute__((ext_vector_type(4)));
typedef float f32x2 __attribute__((ext_vector_type(2)));
typedef unsigned u32x4 __attribute__((ext_vector_type(4)));
typedef unsigned u32x2 __attribute__((ext_vector_type(2)));
constexpr int BM = 256, BK = 64, HALF = 128, HTB = HALF * BK * 2  , STAGE_BYTES = 8 * HTB, NXCD = 8, WGM = 4;

__host__ __device__ __forceinline__ int lds_byte(int r, int c) { const int st = (r >> 4) * 2 + (c >> 5), rr = r & 15, cc = c & 31, ob = rr * 64 + cc * 2; return st * 1024 + (ob ^ (((ob >> 9) & 1) << 5)); }
__host__ __device__ __forceinline__ void stage_rc(int b, int& R, int& C) { const int st = b / 1024, sb = b % 1024, swz = sb ^ (((sb >> 9) & 1) << 5); R = (st >> 1) * 16 + swz / 64; C = (st & 1) * 32 + (swz % 64) / 2; }
__host__ __device__ __forceinline__ int perm32(int rho) { const int n = rho >> 4, i = rho & 15; return 8 * (i >> 2) + 4 * n + (i & 3); }

struct Unit { int pm, pn; };
struct Gemm { const PG8_GAS bf16_t* A; const PG8_GAS bf16_t* Bt; int M, N, K; };

struct StaticOrder {
    int nM, nN, nwg, G, c, wgm;
    __host__ __device__ void init(int M, int N, int G_, int c_, int wgm_ = WGM) { nM = M / BM; nN = N / BM; nwg = nM * nN; G = G_; c = c_; wgm = wgm_; }
    __host__ __device__ bool next(int i, Unit& u) const {
        const long L = (long)i * G + c; if (L >= nwg) return false;
        int wgid = (int)L; { const int q = nwg / NXCD, r = nwg % NXCD, xcd = wgid % NXCD, off = wgid / NXCD; wgid = (xcd < r ? xcd * (q + 1) : r * (q + 1) + (xcd - r) * q) + off; }
        const int nig = wgm * nN, gid = wgid / nig, fm = gid * wgm, gsz = (nM - fm) < wgm ? (nM - fm) : wgm;
        u.pm = fm + ((wgid % nig) % gsz); u.pn = (wgid % nig) / gsz; return true;
    }
    __device__ __forceinline__ void a_ready(const Unit&) const {}
    __device__ __forceinline__ void done(const Unit&) const {}
};

__device__ __forceinline__ unsigned cvt_pk_bf16(float lo, float hi) { unsigned r; asm volatile("v_cvt_pk_bf16_f32 %0, %1, %2" : "=v"(r) : "v"(lo), "v"(hi)); return r; }
__device__ __forceinline__ f32x2 gelu_pk(f32x2 v) {
    const f32x2 av = __builtin_elementwise_abs(v), d = av * 0.2316418882f + 1.0f;
    f32x2 t; t.x = __builtin_amdgcn_rcpf(d.x); t.y = __builtin_amdgcn_rcpf(d.y);
    f32x2 q = t * 0.5307027145f + (-0.7265760135f); q = q * t + 0.7107068705f; q = q * t + (-0.142248368f); q = q * t + 0.127414796f; q = q * t;
    const f32x2 s = (v * v) * (-0.72134752044f);
    f32x2 e; e.x = __builtin_amdgcn_exp2f(s.x); e.y = __builtin_amdgcn_exp2f(s.y);
    const f32x2 m = v * (q * e), r = v - m;
    f32x2 o; o.x = v.x < 0.f ? m.x : r.x; o.y = v.y < 0.f ? m.y : r.y; return o;
}
__device__ __forceinline__ float silu_mul(float g, float u) {
    const float e = __builtin_amdgcn_exp2f(g * -1.44269504089f);
    return g * __builtin_amdgcn_rcpf(1.0f + e) * u;
}
constexpr float RMS_EPS = 1e-6f;
__device__ __forceinline__ float row_rstd(const PG8_GAS float* ssq, int row) {
    const f32x4 a = *(const PG8_GAS f32x4*)(ssq + (size_t)row * 8), b = *(const PG8_GAS f32x4*)(ssq + (size_t)row * 8 + 4);
    const float s = ((a.x + a.y) + (a.z + a.w)) + ((b.x + b.y) + (b.z + b.w));
    return __builtin_amdgcn_rsqf(s * (1.0f / 2048.0f) + RMS_EPS);
}

__device__ __forceinline__ void rows_rstd8(const PG8_GAS float* ssq, int row0, float (&rsv)[2][4]) {
    f32x4 pa[2][4], pb[2][4];
#pragma unroll
    for (int ai = 0; ai < 2; ++ai)
#pragma unroll
        for (int m = 0; m < 4; ++m) { const PG8_GAS f32x4* p = (const PG8_GAS f32x4*)(ssq + (size_t)(row0 + ai * HALF + m * 16) * 8); pa[ai][m] = p[0]; pb[ai][m] = p[1]; }
    __builtin_amdgcn_sched_barrier(0);
#pragma unroll
    for (int ai = 0; ai < 2; ++ai)
#pragma unroll
        for (int m = 0; m < 4; ++m) { const f32x4 a = pa[ai][m], b = pb[ai][m]; const float s = ((a.x + a.y) + (a.z + a.w)) + ((b.x + b.y) + (b.z + b.w));
            rsv[ai][m] = __builtin_amdgcn_rsqf(s * (1.0f / 2048.0f) + RMS_EPS); }
}
constexpr int RRL_MAX = 11;
struct RowRstdLds {
    const PG8_GAS float* ssq; PG8_LAS float* tab;
    template <class Sched> __device__ __forceinline__ void prep_all(const Sched& S, int tid) const {
        if (tid < 256) { f32x4 pa[RRL_MAX], pb[RRL_MAX];
#pragma unroll
            for (int i = 0; i < RRL_MAX; ++i) { Unit u; const bool ok = S.next(i, u); const int row = (ok ? u.pm : 0) * BM + tid; const PG8_GAS f32x4* p = (const PG8_GAS f32x4*)(ssq + (size_t)row * 8); pa[i] = p[0]; pb[i] = p[1]; }
            __builtin_amdgcn_sched_barrier(0);
#pragma unroll
            for (int i = 0; i < RRL_MAX; ++i) { const f32x4 a = pa[i], b = pb[i]; const float s = ((a.x + a.y) + (a.z + a.w)) + ((b.x + b.y) + (b.z + b.w)); tab[i * 256 + tid] = __builtin_amdgcn_rsqf(s * (1.0f / 2048.0f) + RMS_EPS); } }
    }
};

struct EpiGateUp {
    static constexpr bool PERM = true, AFTER_DRAIN = false, ROW_RSTD_LDS = true;
    PG8_GAS bf16_t* O; int ldo; RowRstdLds R;
    __device__ __forceinline__ void operator()(const f32x4 (&acc)[2][2][4][2], const Unit& u, int wr, int wc, int fr, int fq, int ui) const {
        const int row0 = u.pm * BM + wr * 64 + fr, col0 = u.pn * HALF + wc * 32 + 8 * fq;
        float rsv[2][4];
        if (ui < RRL_MAX) { const PG8_LAS float* rt = R.tab + ui * 256 + wr * 64 + fr;
#pragma unroll
            for (int ai = 0; ai < 2; ++ai)
#pragma unroll
                for (int m = 0; m < 4; ++m) rsv[ai][m] = rt[ai * HALF + m * 16]; }
        else rows_rstd8(R.ssq, row0, rsv);
#pragma unroll
        for (int ai = 0; ai < 2; ++ai)
#pragma unroll
            for (int m = 0; m < 4; ++m) { const int row = row0 + ai * HALF + m * 16; const float rs = rsv[ai][m], rs2 = rs * rs, cg = rs * -1.44269504089f;
                u32x4 w;
#pragma unroll
                for (int n = 0; n < 2; ++n) { const f32x4 g = acc[ai][0][m][n], u = acc[ai][1][m][n]; const f32x4 a = g * cg; f32x4 e;
                    e[0] = __builtin_amdgcn_exp2f(a[0]); e[1] = __builtin_amdgcn_exp2f(a[1]); e[2] = __builtin_amdgcn_exp2f(a[2]); e[3] = __builtin_amdgcn_exp2f(a[3]);
                    const f32x4 d = e + 1.0f; f32x4 r;
                    r[0] = __builtin_amdgcn_rcpf(d[0]); r[1] = __builtin_amdgcn_rcpf(d[1]); r[2] = __builtin_amdgcn_rcpf(d[2]); r[3] = __builtin_amdgcn_rcpf(d[3]);
                    const f32x4 o = ((g * u) * rs2) * r;
                    if (n == 0) { w.x = cvt_pk_bf16(o[0], o[1]); w.y = cvt_pk_bf16(o[2], o[3]); } else { w.z = cvt_pk_bf16(o[0], o[1]); w.w = cvt_pk_bf16(o[2], o[3]); } }
                *(PG8_GAS u32x4*)(O + (size_t)row * ldo + col0) = w; }
    }
};
struct EpiZ {
    static constexpr bool PERM = true, AFTER_DRAIN = false, ROW_RSTD_LDS = true;
    PG8_GAS bf16_t* O; int ldo; RowRstdLds R;
    __device__ __forceinline__ void operator()(const f32x4 (&acc)[2][2][4][2], const Unit& u, int wr, int wc, int fr, int fq, int ui) const {
        const int row0 = u.pm * BM + wr * 64 + fr, col0 = u.pn * BM + wc * 32 + 8 * fq;
        float rsv[2][4];
        if (ui < RRL_MAX) { const PG8_LAS float* rt = R.tab + ui * 256 + wr * 64 + fr;
#pragma unroll
            for (int ai = 0; ai < 2; ++ai)
#pragma unroll
                for (int m = 0; m < 4; ++m) rsv[ai][m] = rt[ai * HALF + m * 16]; }
        else rows_rstd8(R.ssq, row0, rsv);
#pragma unroll
        for (int ai = 0; ai < 2; ++ai)
#pragma unroll
            for (int m = 0; m < 4; ++m) { const int row = row0 + ai * HALF + m * 16; const float rs = rsv[ai][m]; PG8_GAS bf16_t* rowp = O + (size_t)row * ldo + col0;
#pragma unroll
                for (int bj = 0; bj < 2; ++bj) { const f32x4 v0 = acc[ai][bj][m][0] * rs, v1 = acc[ai][bj][m][1] * rs;
                    u32x4 w; w.x = cvt_pk_bf16(v0[0], v0[1]); w.y = cvt_pk_bf16(v0[2], v0[3]); w.z = cvt_pk_bf16(v1[0], v1[1]); w.w = cvt_pk_bf16(v1[2], v1[3]);
                    *(PG8_GAS u32x4*)(rowp + bj * HALF) = w; } }
    }
};
struct EpiVT {
    static constexpr bool PERM = true, AFTER_DRAIN = false, ROW_RSTD_LDS = false;
    PG8_GAS bf16_t* O; const PG8_GAS float* ssq;
    __device__ __forceinline__ void operator()(const f32x4 (&acc)[2][2][4][2], const Unit& u, int wr, int wc, int fr, int fq) const {
        const int row0 = u.pm * BM + wr * 64 + fr, tok0 = u.pn * BM + wc * 32 + 8 * fq;
        const int b = tok0 >> 13, s0 = tok0 & 8191;
#pragma unroll
        for (int bj = 0; bj < 2; ++bj) { float rs[8];
            { f32x4 pa[8], pb[8];
#pragma unroll
              for (int j = 0; j < 8; ++j) { const PG8_GAS f32x4* p = (const PG8_GAS f32x4*)(ssq + (size_t)(tok0 + bj * HALF + j) * 8); pa[j] = p[0]; pb[j] = p[1]; }
              __builtin_amdgcn_sched_barrier(0);
#pragma unroll
              for (int j = 0; j < 8; ++j) { const f32x4 a = pa[j], b = pb[j]; const float s = ((a.x + a.y) + (a.z + a.w)) + ((b.x + b.y) + (b.z + b.w)); rs[j] = __builtin_amdgcn_rsqf(s * (1.0f / 2048.0f) + RMS_EPS); } }
#pragma unroll
            for (int ai = 0; ai < 2; ++ai)
#pragma unroll
                for (int m = 0; m < 4; ++m) { const int n = row0 + ai * HALF + m * 16; const f32x4 v0 = acc[ai][bj][m][0], v1 = acc[ai][bj][m][1];
                    u32x4 w; w.x = cvt_pk_bf16(v0[0] * rs[0], v0[1] * rs[1]); w.y = cvt_pk_bf16(v0[2] * rs[2], v0[3] * rs[3]); w.z = cvt_pk_bf16(v1[0] * rs[4], v1[1] * rs[5]); w.w = cvt_pk_bf16(v1[2] * rs[6], v1[3] * rs[7]);
                    *(PG8_GAS u32x4*)(O + ((size_t)(b * 1024 + n) * 8192 + s0 + bj * HALF)) = w; } }
    }
};
struct EpiResid {
    static constexpr bool PERM = true, AFTER_DRAIN = false, ROW_RSTD_LDS = false;
    PG8_GAS float* Xf; PG8_GAS bf16_t* XB; PG8_GAS float* ssq; float scale; PG8_LAS float* scr; int tid;
    __device__ __forceinline__ void operator()(const f32x4 (&acc)[2][2][4][2], const Unit& u, int wr, int wc, int fr, int fq) const {
        const int row0 = u.pm * BM + wr * 64 + fr, col0 = u.pn * BM + wc * 32 + 8 * fq;
        PG8_GAS bf16_t* bp0 = XB + (size_t)row0 * 2048 + col0;
        u32x4 xo[2][4][2];
#pragma unroll
        for (int ai = 0; ai < 2; ++ai)
#pragma unroll
            for (int m = 0; m < 4; ++m)
#pragma unroll
                for (int bj = 0; bj < 2; ++bj) xo[ai][m][bj] = *(const PG8_GAS u32x4*)(bp0 + (size_t)(ai * HALF + m * 16) * 2048 + bj * HALF);
        float ssv[2][4];
#pragma unroll
        for (int ai = 0; ai < 2; ++ai)
#pragma unroll
            for (int m = 0; m < 4; ++m) { float ss = 0.f;
#pragma unroll
                for (int bj = 0; bj < 2; ++bj) { const u32x4 x = xo[ai][m][bj];
                    f32x4 y0, y1;
                    y0[0] = __builtin_bit_cast(float, x.x << 16) + acc[ai][bj][m][0][0] * scale; y0[1] = __builtin_bit_cast(float, x.x & 0xffff0000u) + acc[ai][bj][m][0][1] * scale;
                    y0[2] = __builtin_bit_cast(float, x.y << 16) + acc[ai][bj][m][0][2] * scale; y0[3] = __builtin_bit_cast(float, x.y & 0xffff0000u) + acc[ai][bj][m][0][3] * scale;
                    y1[0] = __builtin_bit_cast(float, x.z << 16) + acc[ai][bj][m][1][0] * scale; y1[1] = __builtin_bit_cast(float, x.z & 0xffff0000u) + acc[ai][bj][m][1][1] * scale;
                    y1[2] = __builtin_bit_cast(float, x.w << 16) + acc[ai][bj][m][1][2] * scale; y1[3] = __builtin_bit_cast(float, x.w & 0xffff0000u) + acc[ai][bj][m][1][3] * scale;
                    u32x4 w; w.x = cvt_pk_bf16(y0[0], y0[1]); w.y = cvt_pk_bf16(y0[2], y0[3]); w.z = cvt_pk_bf16(y1[0], y1[1]); w.w = cvt_pk_bf16(y1[2], y1[3]);
                    *(PG8_GAS u32x4*)(bp0 + (size_t)(ai * HALF + m * 16) * 2048 + bj * HALF) = w;
                    ss += ((y0[0] * y0[0] + y0[1] * y0[1]) + (y0[2] * y0[2] + y0[3] * y0[3])) + ((y1[0] * y1[0] + y1[1] * y1[1]) + (y1[2] * y1[2] + y1[3] * y1[3])); }
                ssv[ai][m] = ss; }
        { float t[2][4];
#pragma unroll
          for (int ai = 0; ai < 2; ++ai)
#pragma unroll
              for (int m = 0; m < 4; ++m) t[ai][m] = __shfl_xor(ssv[ai][m], 16);
#pragma unroll
          for (int ai = 0; ai < 2; ++ai)
#pragma unroll
              for (int m = 0; m < 4; ++m) ssv[ai][m] += t[ai][m];
#pragma unroll
          for (int ai = 0; ai < 2; ++ai)
#pragma unroll
              for (int m = 0; m < 4; ++m) t[ai][m] = __shfl_xor(ssv[ai][m], 32);
#pragma unroll
          for (int ai = 0; ai < 2; ++ai)
#pragma unroll
              for (int m = 0; m < 4; ++m) { if (fq == 0) scr[(ai * HALF + wr * 64 + m * 16 + fr) * 4 + wc] = ssv[ai][m] + t[ai][m]; } }
        if (Xf) {
            PG8_GAS float* xp0 = Xf + (size_t)row0 * 2048 + col0;
#pragma unroll
            for (int ai = 0; ai < 2; ++ai)
#pragma unroll
                for (int m = 0; m < 4; ++m)
#pragma unroll
                    for (int bj = 0; bj < 2; ++bj) { const u32x4 x = xo[ai][m][bj];
                        f32x4 y0, y1;
                        y0[0] = __builtin_bit_cast(float, x.x << 16) + acc[ai][bj][m][0][0] * scale; y0[1] = __builtin_bit_cast(float, x.x & 0xffff0000u) + acc[ai][bj][m][0][1] * scale;
                        y0[2] = __builtin_bit_cast(float, x.y << 16) + acc[ai][bj][m][0][2] * scale; y0[3] = __builtin_bit_cast(float, x.y & 0xffff0000u) + acc[ai][bj][m][0][3] * scale;
                        y1[0] = __builtin_bit_cast(float, x.z << 16) + acc[ai][bj][m][1][0] * scale; y1[1] = __builtin_bit_cast(float, x.z & 0xffff0000u) + acc[ai][bj][m][1][1] * scale;
                        y1[2] = __builtin_bit_cast(float, x.w << 16) + acc[ai][bj][m][1][2] * scale; y1[3] = __builtin_bit_cast(float, x.w & 0xffff0000u) + acc[ai][bj][m][1][3] * scale;
                        PG8_GAS float* xp = xp0 + (size_t)(ai * HALF + m * 16) * 2048 + bj * HALF; *(PG8_GAS f32x4*)xp = y0; *(PG8_GAS f32x4*)(xp + 4) = y1; }
        }
        asm volatile("s_waitcnt lgkmcnt(0)" ::: "memory"); __builtin_amdgcn_s_barrier(); asm volatile("" ::: "memory");
        if (tid < 256) { const f32x4 p = *(const PG8_LAS f32x4*)(scr + tid * 4); ssq[(size_t)(u.pm * BM + tid) * 8 + u.pn] = (p.x + p.y) + (p.z + p.w); }
    }
};

template <class Epi, class Sched, bool ALIGN_EPI = false, bool SP2 = false, bool KREV = false>
__device__ __forceinline__ void gemm_phase(PG8_LAS unsigned char* lds, const Gemm g, const Sched& S, const Epi& E, int tid_in) {
    int tid_ = tid_in; asm volatile("" : "+v"(tid_));
    const int tid = tid_, wid = __builtin_amdgcn_readfirstlane(tid >> 6), lane = tid & 63, wr = wid >> 2, wc = wid & 3, fr = lane & 15, fq = lane >> 4;
    const int K = g.K, nt = K / BK;
    unsigned voffA[2], voffB[2];
#pragma unroll
    for (int i = 0; i < 2; ++i) { int R, C; stage_rc(tid * 16 + i * 8192, R, C); const int Rb = Epi::PERM ? ((R & ~31) + perm32(R & 31)) : R;
        voffA[i] = (unsigned)(R * K + C) * 2u; voffB[i] = (unsigned)(Rb * K + C) * 2u; }
    const ptrdiff_t kstep = KREV ? -(ptrdiff_t)(BK * 2) : (ptrdiff_t)(BK * 2);
    const size_t hstep = (size_t)HALF * K * 2;
    const size_t tstep = 2 * hstep;
    const unsigned ldsw = (unsigned)wid * 1024u;
    const int aoff = lds_byte(wr * 64 + fr, fq * 8), boff = lds_byte(wc * 32 + fr, fq * 8);
#define PG8_SA(b, h) (((b) * 2 + (h)) * HTB)
#define PG8_SB(b, h) ((4 + (b) * 2 + (h)) * HTB)
#define PG8_STAGE(bufoff, gbase, voff) do { _Pragma("unroll") for (int _i = 0; _i < 2; ++_i) \
        __builtin_amdgcn_global_load_lds((const PG8_GAS unsigned*)((const PG8_GAS char*)(gbase) + (voff)[_i]), (PG8_LAS unsigned*)(lds + (bufoff) + ldsw + _i * 8192), 16, 0, 0); } while (0)
#define PG8_LDA(dst, b, h) do { _Pragma("unroll") for (int m = 0; m < 4; ++m) _Pragma("unroll") for (int k = 0; k < 2; ++k) dst[m][k] = *(const PG8_LAS bf16x8*)(lds + PG8_SA(b, h) + aoff + m * 2048 + k * 1024); } while (0)
#define PG8_LDB(dst, b, h) do { _Pragma("unroll") for (int n = 0; n < 2; ++n) _Pragma("unroll") for (int k = 0; k < 2; ++k) dst[n][k] = *(const PG8_LAS bf16x8*)(lds + PG8_SB(b, h) + boff + n * 2048 + k * 1024); } while (0)
#define PG8_MMA(ai, bj, At, Bt) do { __builtin_amdgcn_s_setprio(1); _Pragma("unroll") for (int m = 0; m < 4; ++m) _Pragma("unroll") for (int n = 0; n < 2; ++n) _Pragma("unroll") for (int k = 0; k < 2; ++k) \
        acc[ai][bj][m][n] = __builtin_amdgcn_mfma_f32_16x16x32_bf16(Bt[n][k], At[m][k], acc[ai][bj][m][n], 0, 0, 0); __builtin_amdgcn_s_setprio(0); } while (0)
#define PG8_WAIT_V(n) asm volatile("s_waitcnt vmcnt(" #n ")" ::: "memory")
#define PG8_WAIT_L(n) asm volatile("s_waitcnt lgkmcnt(" #n ")" ::: "memory")
#define PG8_BAR __builtin_amdgcn_s_barrier()
#define PG8_SCHED __builtin_amdgcn_sched_barrier(0)
    Unit cur, nxt; int ui = 0;
    if (!S.next(0, cur)) return;
    f32x4 acc[2][2][4][2];
#pragma unroll
    for (int a = 0; a < 2; ++a)
#pragma unroll
        for (int b = 0; b < 2; ++b)
#pragma unroll
            for (int m = 0; m < 4; ++m)
#pragma unroll
                for (int n = 0; n < 2; ++n) acc[a][b][m][n] = (f32x4){0.f, 0.f, 0.f, 0.f};
    bf16x8 At[4][2], B0[2][2], B1[2][2];
    const size_t k0off = KREV ? (size_t)(nt - 1) * (size_t)(BK * 2) : (size_t)0;
    const PG8_GAS char* cA = (const PG8_GAS char*)g.A + (size_t)cur.pm * tstep + k0off; const PG8_GAS char* cB = (const PG8_GAS char*)g.Bt + (size_t)cur.pn * tstep + k0off;
    S.a_ready(cur);
    if constexpr (Epi::ROW_RSTD_LDS) E.R.prep_all(S, tid);
    if constexpr (SP2) {
        PG8_STAGE(PG8_SB(0, 0), cB, voffB); PG8_STAGE(PG8_SB(0, 1), cB + hstep, voffB); PG8_STAGE(PG8_SA(0, 0), cA, voffA); PG8_STAGE(PG8_SA(0, 1), cA + hstep, voffA);
        if (wr == 1) PG8_BAR;
        PG8_WAIT_V(2); PG8_BAR;
        PG8_STAGE(PG8_SB(1, 0), cB + kstep, voffB); PG8_STAGE(PG8_SA(1, 0), cA + kstep, voffA); PG8_STAGE(PG8_SB(1, 1), cB + hstep + kstep, voffB);
        PG8_WAIT_V(6); PG8_BAR;
    } else {
        PG8_STAGE(PG8_SB(0, 0), cB, voffB); PG8_STAGE(PG8_SA(0, 0), cA, voffA); PG8_STAGE(PG8_SB(0, 1), cB + hstep, voffB); PG8_STAGE(PG8_SA(0, 1), cA + hstep, voffA);
        if (wr == 1) PG8_BAR;
        PG8_WAIT_V(4); PG8_BAR;
        PG8_STAGE(PG8_SB(1, 0), cB + kstep, voffB); PG8_STAGE(PG8_SA(1, 0), cA + kstep, voffA); PG8_STAGE(PG8_SB(1, 1), cB + hstep + kstep, voffB);
        PG8_WAIT_V(6); PG8_BAR;
    }
    for (;;) {
        const bool has_next = S.next(ui + 1, nxt);
        const PG8_GAS char* nA = has_next ? (const PG8_GAS char*)g.A + (size_t)nxt.pm * tstep + k0off : cA; const PG8_GAS char* nB = has_next ? (const PG8_GAS char*)g.Bt + (size_t)nxt.pn * tstep + k0off : cB;
        for (int t = 0; t < nt; t += 2) {
            const bool last = (t == nt - 2);
            const PG8_GAS char* a1 = cA + (ptrdiff_t)(t + 1) * kstep;
            const PG8_GAS char* a2 = last ? nA : cA + (ptrdiff_t)(t + 2) * kstep; const PG8_GAS char* b2 = last ? nB : cB + (ptrdiff_t)(t + 2) * kstep;
            const PG8_GAS char* a3 = a2 + kstep; const PG8_GAS char* b3 = b2 + kstep;
            if (last && has_next) S.a_ready(nxt);
            if constexpr (SP2) {
            PG8_LDB(B0, 0, 0); PG8_LDB(B1, 0, 1); PG8_SCHED; PG8_LDA(At, 0, 0); PG8_STAGE(PG8_SA(1, 1), a1 + hstep, voffA);
            PG8_WAIT_V(8); PG8_WAIT_L(0); PG8_BAR; PG8_MMA(0, 0, At, B0); PG8_MMA(0, 1, At, B1); PG8_BAR; PG8_SCHED;
            PG8_LDA(At, 0, 1); PG8_STAGE(PG8_SB(0, 0), b2, voffB); PG8_STAGE(PG8_SB(0, 1), b2 + hstep, voffB); PG8_STAGE(PG8_SA(0, 0), a2, voffA);
            PG8_WAIT_V(8); PG8_WAIT_L(0); PG8_BAR; PG8_MMA(1, 0, At, B0); PG8_MMA(1, 1, At, B1); PG8_BAR; PG8_SCHED;
            PG8_LDB(B0, 1, 0); PG8_LDB(B1, 1, 1); PG8_SCHED; PG8_LDA(At, 1, 0); PG8_STAGE(PG8_SA(0, 1), a2 + hstep, voffA);
            PG8_WAIT_V(8); PG8_WAIT_L(0); PG8_BAR; PG8_MMA(0, 0, At, B0); PG8_MMA(0, 1, At, B1); PG8_BAR; PG8_SCHED;
            PG8_LDA(At, 1, 1); PG8_STAGE(PG8_SB(1, 0), b3, voffB); PG8_STAGE(PG8_SB(1, 1), b3 + hstep, voffB); PG8_STAGE(PG8_SA(1, 0), a3, voffA);
            PG8_WAIT_V(8); PG8_WAIT_L(0); PG8_BAR; PG8_MMA(1, 0, At, B0); PG8_MMA(1, 1, At, B1); PG8_BAR; PG8_SCHED;
            } else {
            PG8_LDB(B0, 0, 0); PG8_SCHED; PG8_LDA(At, 0, 0); PG8_STAGE(PG8_SA(1, 1), a1 + hstep, voffA);
            PG8_WAIT_L(8); PG8_BAR; PG8_WAIT_L(0); PG8_MMA(0, 0, At, B0); PG8_BAR; PG8_SCHED;
            PG8_LDB(B1, 0, 1); PG8_STAGE(PG8_SB(0, 0), b2, voffB);
            PG8_BAR; PG8_WAIT_L(0); PG8_MMA(0, 1, At, B1); PG8_BAR;
            PG8_LDA(At, 0, 1); PG8_STAGE(PG8_SA(0, 0), a2, voffA);
            PG8_BAR; PG8_WAIT_L(0); PG8_MMA(1, 0, At, B0); PG8_BAR; PG8_SCHED;
            PG8_STAGE(PG8_SB(0, 1), b2 + hstep, voffB);
            PG8_WAIT_V(6); PG8_BAR; PG8_MMA(1, 1, At, B1); PG8_BAR;
            PG8_LDB(B0, 1, 0); PG8_SCHED; PG8_LDA(At, 1, 0); PG8_STAGE(PG8_SA(0, 1), a2 + hstep, voffA);
            PG8_WAIT_L(8); PG8_BAR; PG8_WAIT_L(0); PG8_MMA(0, 0, At, B0); PG8_BAR; PG8_SCHED;
            PG8_LDB(B1, 1, 1); PG8_STAGE(PG8_SB(1, 0), b3, voffB);
            PG8_BAR; PG8_WAIT_L(0); PG8_MMA(0, 1, At, B1); PG8_BAR;
            PG8_LDA(At, 1, 1); PG8_STAGE(PG8_SA(1, 0), a3, voffA);
            PG8_BAR; PG8_WAIT_L(0); PG8_MMA(1, 0, At, B0); PG8_BAR; PG8_SCHED;
            PG8_STAGE(PG8_SB(1, 1), b3 + hstep, voffB);
            PG8_WAIT_V(6); PG8_BAR; PG8_MMA(1, 1, At, B1); PG8_BAR;
            }
        }
        if constexpr (ALIGN_EPI) { if (wr == 0) PG8_BAR; }
        if constexpr (!Epi::AFTER_DRAIN) { if constexpr (Epi::ROW_RSTD_LDS) E(acc, cur, wr, wc, fr, fq, ui); else E(acc, cur, wr, wc, fr, fq); S.done(cur); }
        if (!has_next) break;
#pragma unroll
        for (int a = 0; a < 2; ++a)
#pragma unroll
            for (int b = 0; b < 2; ++b)
#pragma unroll
                for (int m = 0; m < 4; ++m)
#pragma unroll
                    for (int n = 0; n < 2; ++n) acc[a][b][m][n] = (f32x4){0.f, 0.f, 0.f, 0.f};
        cur = nxt; cA = nA; cB = nB; ++ui;
        if constexpr (ALIGN_EPI) { if (wr == 1) PG8_BAR; }
    }
    PG8_WAIT_V(0);
    if constexpr (!ALIGN_EPI) { if (wr == 0) PG8_BAR; }
    PG8_BAR;
#undef PG8_SA
#undef PG8_SB
#undef PG8_STAGE
#undef PG8_LDA
#undef PG8_LDB
#undef PG8_MMA
#undef PG8_WAIT_V
#undef PG8_WAIT_L
#undef PG8_BAR
#undef PG8_SCHED
}
}

constexpr int NWAVES = 8;
constexpr int DEPTH = 4, BATCH = 2, SEQ = 8192, D = 2048, FF = 5632, NGU = 2 * FF, INC = 4608, ZW = 3584, NVT = 1024;
constexpr int M = BATCH * SEQ;
constexpr int GRID_W = 64, GRID_ROWS = SEQ / GRID_W;
constexpr float NA_SCALE = 0.08838834764831845f;

constexpr size_t MiB = 1u << 20;
constexpr size_t WS_CTL = 0, CTL_ZERO_BYTES = 1 * MiB;
constexpr size_t WS_SSQ = 1 * MiB;
constexpr size_t WS_SGW = 2 * MiB;
constexpr size_t WS_PWT = 3 * MiB;
constexpr size_t WS_W = 4 * MiB;
constexpr size_t LW_GU1 = 0, LW_D1 = 44 * MiB, LW_IN = 66 * MiB, LW_OUT = 84 * MiB, LW_GU2 = 92 * MiB, LW_D2 = 136 * MiB, LW_BYTES = 158 * MiB;
constexpr size_t WS_XB = WS_W + DEPTH * LW_BYTES;
constexpr size_t WS_ACT = WS_XB + 64 * MiB;
constexpr size_t WS_Z = WS_ACT + 176 * MiB;
constexpr size_t WS_VT = WS_Z + 112 * MiB;
constexpr size_t WS_MIX = WS_VT + 32 * MiB;
constexpr size_t WS_END = WS_MIX + 64 * MiB;
static_assert((size_t)NGU * D * 2 == 44 * MiB && (size_t)D * FF * 2 == 22 * MiB && (size_t)INC * D * 2 == 18 * MiB && (size_t)D * D * 2 == 8 * MiB, "weight sizes");
static_assert((size_t)M * FF * 2 == 176 * MiB && (size_t)M * ZW * 2 == 112 * MiB, "activation sizes");
constexpr int CW_BAR = 4096;

constexpr int RING_OFF = 0, RING_BYTES = 131072;
constexpr int SCR_OFF = RING_BYTES;
constexpr int LDSCTL_OFF = SCR_OFF + 16384, MISC_OFF = LDSCTL_OFF + 320;
constexpr int LDS_BYTES = LDSCTL_OFF + 1024;
static_assert(pg8::RRL_MAX * 1024 <= 16384 && LDS_BYTES <= 163840, "LDS scratch");
static_assert(MISC_OFF + 128 <= LDS_BYTES, "LDS map");
constexpr int VT_PITCH = 272;
constexpr int RPB_OFF = 98304;

#define GAS __attribute__((address_space(1)))
#define LAS __attribute__((address_space(3)))
typedef unsigned short bf16;
typedef unsigned v4u __attribute__((ext_vector_type(4)));
typedef unsigned v2u __attribute__((ext_vector_type(2)));
typedef float f32x4 __attribute__((ext_vector_type(4)));
typedef float f32x2 __attribute__((ext_vector_type(2)));
typedef short bf16x8 __attribute__((ext_vector_type(8)));
typedef GAS unsigned gu32;
#define RLX_AGENT __ATOMIC_RELAXED, __HIP_MEMORY_SCOPE_AGENT
#define LDS_WAIT() asm volatile("s_waitcnt lgkmcnt(0)" ::: "memory")
#define VM_WAIT() asm volatile("s_waitcnt vmcnt(0)" ::: "memory")
__device__ __forceinline__ unsigned f2bf(float f) { unsigned u = __builtin_bit_cast(unsigned, f); return (u + 0x7fffu + ((u >> 16) & 1u)) >> 16; }
__device__ __forceinline__ unsigned pk2(float lo, float hi) { return f2bf(lo) | (f2bf(hi) << 16); }
__device__ __forceinline__ float bf_lo(unsigned w) { return __builtin_bit_cast(float, w << 16); }
__device__ __forceinline__ float bf_hi(unsigned w) { return __builtin_bit_cast(float, w & 0xffff0000u); }

#define XB_TMO      128
#define XB_XCNT(j)  (256  + 64 * (j))
#define XB_XSUB(j)  (1280 + 64 * (j))
#define XB_XGEN(j)  (2304 + 64 * (j))
#define XB_TOP      3328
#define XB_TOPGEN   3392
#define XCD_BAR_WORDS 3456
#define XB_SPIN_CAP (1u << 18)

typedef GAS unsigned* xbp;
__device__ __forceinline__ unsigned xb_ld(xbp p)              { return __hip_atomic_load(p, __ATOMIC_RELAXED, __HIP_MEMORY_SCOPE_AGENT); }
__device__ __forceinline__ unsigned xb_add(xbp p, unsigned v) { return __hip_atomic_fetch_add(p, v, __ATOMIC_RELAXED, __HIP_MEMORY_SCOPE_AGENT); }
__device__ __forceinline__ unsigned xb_xcc_id() { return (unsigned)__builtin_amdgcn_s_getreg((3 << 11) | 20) & 0xFu; }
#define XB_SPIN(cond, bar) do { unsigned _sp = 0; while (cond) { __builtin_amdgcn_s_sleep(1); \
    if ((++_sp & 255u) == 0u) { if (xb_ld(&(bar)[XB_TMO])) break; if (_sp > XB_SPIN_CAP) { xb_add(&(bar)[XB_TMO], 1u); break; } } } } while (0)

struct XcdBarrier {
    xbp bar; unsigned x;
    volatile LAS unsigned* st;
    bool t0;
};
__device__ __forceinline__ XcdBarrier xcd_barrier_post(xbp bar, volatile LAS unsigned* st) {
    XcdBarrier b; b.bar = bar; b.x = xb_xcc_id(); b.st = st; b.t0 = (threadIdx.x == 0);
    if (b.t0) (void)xb_add(&bar[XB_XCNT(b.x)], 1u);
    return b;
}
__device__ __forceinline__ void xcd_barrier_complete(xbp bar, unsigned x, unsigned& nloc, unsigned& nx) {
    const unsigned G = gridDim.x * gridDim.y * gridDim.z;
    unsigned sum, cnt, mine, sp = 0u;
    for (;;) {
        sum = 0u; cnt = 0u; mine = 0u;
#pragma unroll
        for (unsigned j = 0; j < 16; ++j) { const unsigned c = xb_ld(&bar[XB_XCNT(j)]); sum += c; cnt += (c > 0u) ? 1u : 0u; mine = (j == x) ? c : mine; }
        if (sum == G) break;
        __builtin_amdgcn_s_sleep(1);
        if ((++sp & 255u) == 0u) { if (xb_ld(&bar[XB_TMO])) break; if (sp > XB_SPIN_CAP) { xb_add(&bar[XB_TMO], 1u); break; } }
    }
    nloc = mine > 0u ? mine : 1u; nx = cnt > 0u ? cnt : 1u;
}
__device__ __forceinline__ void xcd_barrier(const XcdBarrier& b) {
    asm volatile("s_waitcnt vmcnt(0)" ::: "memory");
    __syncthreads();
    if (b.t0) {
        xbp bar = b.bar;
        __builtin_amdgcn_s_waitcnt(0);
        unsigned nloc = b.st[0], nx = b.st[1];
        if (nloc == 0u) { xcd_barrier_complete(bar, b.x, nloc, nx); b.st[0] = nloc; b.st[1] = nx; }
        const unsigned old = xb_add(&bar[XB_XSUB(b.x)], 1u);
        const unsigned gen = old / nloc;
        if (old + 1u == (gen + 1u) * nloc) {
            __builtin_amdgcn_fence(__ATOMIC_RELEASE, "agent");
            asm volatile("s_waitcnt vmcnt(0)" ::: "memory");
            const unsigned og = xb_add(&bar[XB_TOP], 1u);
            const unsigned tg = og / nx;
            if (og + 1u == (tg + 1u) * nx) xb_add(&bar[XB_TOPGEN], 1u);
            else XB_SPIN(xb_ld(&bar[XB_TOPGEN]) == tg, bar);
            __builtin_amdgcn_fence(__ATOMIC_ACQUIRE, "agent");
            xb_add(&bar[XB_XGEN(b.x)], 1u);
            asm volatile("s_waitcnt vmcnt(0)" ::: "memory");
        } else {
            XB_SPIN(xb_ld(&bar[XB_XGEN(b.x)]) == gen, bar);
            __builtin_amdgcn_fence(__ATOMIC_ACQUIRE, "agent");
            asm volatile("s_waitcnt vmcnt(0)" ::: "memory");
        }
    }
    __syncthreads();
}

typedef GAS unsigned char* gptr;
typedef const GAS float* gcf32;
typedef GAS bf16* gbf;
typedef const GAS bf16* gcbf;
struct Args { const float* in[19]; float* out; unsigned char* ws; };
typedef const __attribute__((address_space(4))) Args* kargp;
struct Frame {
    LAS unsigned char* lds;
    int tid, lane, wave;
    int G, bid;
    GAS float* X;
    gptr ws;
    kargp ap;
    __device__ __forceinline__ gbf XB() const { return (gbf)(ws + WS_XB); }
    __device__ __forceinline__ gbf ACT() const { return (gbf)(ws + WS_ACT); }
    __device__ __forceinline__ gbf Z() const { return (gbf)(ws + WS_Z); }
    __device__ __forceinline__ gbf VT() const { return (gbf)(ws + WS_VT); }
    __device__ __forceinline__ gbf MIX() const { return (gbf)(ws + WS_MIX); }
    __device__ __forceinline__ gbf SGW() const { return (gbf)(ws + WS_SGW); }
    __device__ __forceinline__ gbf PWT() const { return (gbf)(ws + WS_PWT); }
    __device__ __forceinline__ GAS float* SSQ() const { return (GAS float*)(ws + WS_SSQ); }
};
#define ARG_IN(k) ((gcf32)F.ap->in[k])

__device__ __forceinline__ float wave_sum(float v) {
#pragma unroll
    for (int o = 1; o < 64; o <<= 1) v += __shfl_xor(v, o);
    return v;
}

__device__ __forceinline__ void p0_transpose_item(gcf32 W, int K, int N, gbf WT, int rowmode, gcf32 gain, LAS float* scr, int item, int lane) {
    const int nblk = N / 32, kb = item / nblk, nb = item % nblk, k0 = 64 * kb, n0 = 32 * nb;
    int rowbase = n0;
    if (rowmode == 1) rowbase = 256 * (n0 >> 7) + (n0 & 127);
    if (rowmode == 2) rowbase = 256 * (n0 >> 7) + 128 + (n0 & 127);
#pragma unroll 8
    for (int i = 0; i < 32; ++i) { const int kk = 2 * i + (lane >> 5); float v = W[(size_t)(k0 + kk) * N + n0 + (lane & 31)]; if (gain) v *= gain[k0 + kk]; scr[kk * 33 + (lane & 31)] = v; }
    LDS_WAIT(); asm volatile("" ::: "memory");
    const int c = lane & 7;
#pragma unroll
    for (int j = 0; j < 4; ++j) { const int n = (lane >> 3) + 8 * j; const LAS float* s = scr + (8 * c) * 33 + n;
        v4u o; o.x = pk2(s[0 * 33], s[1 * 33]); o.y = pk2(s[2 * 33], s[3 * 33]); o.z = pk2(s[4 * 33], s[5 * 33]); o.w = pk2(s[6 * 33], s[7 * 33]);
        *(GAS v4u*)(WT + (size_t)(rowbase + n) * K + k0 + 8 * c) = o; }
    LDS_WAIT(); asm volatile("" ::: "memory");
}

struct P0Tile { gcf32 W; gcf32 gain; gbf WT; int K, N, rowmode, k0, n0, has_gain; };
constexpr int P0_SLOT = 8192 + 256;
static_assert(NWAVES * 2 * P0_SLOT <= LDSCTL_OFF, "prologue slots fit below the LDS control words");
constexpr int P0_T_G = (D / 64) * (FF / 256), P0_T_D = (FF / 64) * (D / 256), P0_T_IN = (D / 64) * (INC / 256), P0_T_OUT = (D / 64) * (D / 256);
constexpr int P0_PER_LAYER = 4 * P0_T_G + 2 * P0_T_D + P0_T_IN + P0_T_OUT, P0_TOTAL = DEPTH * P0_PER_LAYER;
__device__ __forceinline__ void p0_tile_decode(const Frame& F, int T, P0Tile& t) {
    constexpr int T_G = P0_T_G, T_D = P0_T_D, T_IN = P0_T_IN, T_OUT = P0_T_OUT;
    const int l = T / P0_PER_LAYER; int r = T % P0_PER_LAYER;
    gptr wl = F.ws + WS_W + (size_t)l * LW_BYTES; const size_t oG = (size_t)l * D * FF;
    int nblk;
    if (r < T_G)                { t.W = ARG_IN(2) + oG;  t.gain = ARG_IN(1) + l * D;  t.WT = (gbf)(wl + LW_GU1); t.K = D;  t.N = FF;  t.rowmode = 1; }
    else if ((r -= T_G) < T_G)  { t.W = ARG_IN(3) + oG;  t.gain = ARG_IN(1) + l * D;  t.WT = (gbf)(wl + LW_GU1); t.K = D;  t.N = FF;  t.rowmode = 2; }
    else if ((r -= T_G) < T_D)  { t.W = ARG_IN(4) + oG;  t.gain = ARG_IN(4) + oG;     t.WT = (gbf)(wl + LW_D1);  t.K = FF; t.N = D;   t.rowmode = 0; }
    else if ((r -= T_D) < T_IN) { t.W = ARG_IN(6) + (size_t)l * D * INC; t.gain = ARG_IN(5) + l * D; t.WT = (gbf)(wl + LW_IN); t.K = D; t.N = INC; t.rowmode = 0; }
    else if ((r -= T_IN) < T_OUT) { t.W = ARG_IN(13) + (size_t)l * D * D; t.gain = ARG_IN(13);  t.WT = (gbf)(wl + LW_OUT); t.K = D;  t.N = D;   t.rowmode = 0; }
    else if ((r -= T_OUT) < T_G) { t.W = ARG_IN(15) + oG; t.gain = ARG_IN(14) + l * D; t.WT = (gbf)(wl + LW_GU2); t.K = D;  t.N = FF;  t.rowmode = 1; }
    else if ((r -= T_G) < T_G)  { t.W = ARG_IN(16) + oG; t.gain = ARG_IN(14) + l * D; t.WT = (gbf)(wl + LW_GU2); t.K = D;  t.N = FF;  t.rowmode = 2; }
    else { r -= T_G;              t.W = ARG_IN(17) + oG; t.gain = ARG_IN(17) + oG;    t.WT = (gbf)(wl + LW_D2);  t.K = FF; t.N = D;   t.rowmode = 0; }
    t.has_gain = (t.rowmode != 0) || (t.N == INC);
    nblk = t.N / 256; t.k0 = 64 * (r / nblk); t.n0 = 256 * (r % nblk);
}
__device__ __forceinline__ void p0_strip_issue(const P0Tile& t, int w, int lane, LAS unsigned char* slot) {
    gcf32 src = t.W + (size_t)(t.k0 + (lane >> 3)) * t.N + t.n0 + 32 * w;
#pragma unroll
    for (int j = 0; j < 8; ++j) __builtin_amdgcn_global_load_lds((const GAS unsigned*)(src + (size_t)(8 * j) * t.N + 4 * ((lane & 7) ^ j)), (LAS unsigned*)(slot + j * 1024), 16, 0, 0);
    __builtin_amdgcn_global_load_lds((const GAS unsigned*)(t.gain + t.k0 + lane), (LAS unsigned*)(slot + 8192), 4, 0, 0);
}
__device__ __forceinline__ void p0_strip_finish(const P0Tile& t, int w, int lane, const LAS unsigned char* slot) {
    const int k8 = lane & 7, nl = lane >> 3;
    float g[8];
    { const f32x4 ga = *(const LAS f32x4*)(slot + 8192 + 32 * k8), gb = *(const LAS f32x4*)(slot + 8192 + 32 * k8 + 16);
      g[0] = ga.x; g[1] = ga.y; g[2] = ga.z; g[3] = ga.w; g[4] = gb.x; g[5] = gb.y; g[6] = gb.z; g[7] = gb.w;
#pragma unroll
      for (int i = 0; i < 8; ++i) g[i] = t.has_gain ? g[i] : 1.f; }
#pragma unroll
    for (int q = 0; q < 4; ++q) { const int n = nl + 8 * q;
        const LAS float* s = (const LAS float*)slot + (8 * k8) * 32 + 4 * ((n >> 2) ^ k8) + (n & 3);
        v4u o; o.x = pg8::cvt_pk_bf16(s[0] * g[0], s[32] * g[1]); o.y = pg8::cvt_pk_bf16(s[64] * g[2], s[96] * g[3]);
        o.z = pg8::cvt_pk_bf16(s[128] * g[4], s[160] * g[5]); o.w = pg8::cvt_pk_bf16(s[192] * g[6], s[224] * g[7]);
        const int nn = t.n0 + 32 * w + n; int row = nn;
        if (t.rowmode == 1) row = 256 * (nn >> 7) + (nn & 127);
        if (t.rowmode == 2) row = 256 * (nn >> 7) + 128 + (nn & 127);
        *(GAS v4u*)(t.WT + (size_t)row * t.K + t.k0 + 8 * k8) = o; }
}

__device__ __forceinline__ void p0_convert_tiles(Frame& F, int first, int stride, int nT) {
    LAS unsigned char* slot0 = F.lds + RING_OFF + F.wave * (2 * P0_SLOT); LAS unsigned char* slot1 = slot0 + P0_SLOT;
    P0Tile ta, tb; const int w = F.wave;
    p0_tile_decode(F, first, ta); p0_strip_issue(ta, w, F.lane, slot0);
    for (int i = 0; i < nT; i += 2) {
        p0_tile_decode(F, first + min(i + 1, nT - 1) * stride, tb); p0_strip_issue(tb, w, F.lane, slot1);
        asm volatile("s_waitcnt vmcnt(9)" ::: "memory");
        p0_strip_finish(ta, w, F.lane, slot0);
        if (i + 1 >= nT) break;
        p0_tile_decode(F, first + min(i + 2, nT - 1) * stride, ta); p0_strip_issue(ta, w, F.lane, slot0);
        asm volatile("s_waitcnt vmcnt(9)" ::: "memory");
        p0_strip_finish(tb, w, F.lane, slot1);
    }
    VM_WAIT(); LDS_WAIT(); __builtin_amdgcn_s_barrier();
}
constexpr int P0_LATE_GRID = 256, P0_LATE_PER_WG = 22, P0_LATE_SLOTS = 3, P0_LATE_PER_SLOT = 128 * P0_LATE_PER_WG, P0_LATE = P0_LATE_SLOTS * P0_LATE_PER_SLOT;
static_assert(P0_TOTAL - P0_LATE >= 1 * P0_PER_LAYER && P0_TOTAL - P0_LATE + 1 * P0_LATE_PER_SLOT >= 2 * P0_PER_LAYER && P0_TOTAL - P0_LATE + 2 * P0_LATE_PER_SLOT >= 3 * P0_PER_LAYER, "slot l converts tiles of layers > l only");
__device__ __forceinline__ void p0_late_slot(Frame& F, int l) {
    if (F.G != P0_LATE_GRID || l >= P0_LATE_SLOTS || F.bid < 128) return;
    p0_convert_tiles(F, P0_TOTAL - P0_LATE + l * P0_LATE_PER_SLOT + (F.bid - 128), 128, P0_LATE_PER_WG);
}

__device__ __forceinline__ void p0_prologue(Frame& F) {
    { const int early = (F.G == P0_LATE_GRID) ? P0_TOTAL - P0_LATE : P0_TOTAL; const int c = F.bid, G = F.G;
      if (c < early) p0_convert_tiles(F, c, G, (early - c + G - 1) / G); }
    LAS float* scr = (LAS float*)(F.lds + RING_OFF + F.wave * 16384);
    const int gw = F.bid * NWAVES + F.wave, NGW = F.G * NWAVES;
    for (int it = gw; it < DEPTH * 4 * 8; it += NGW) { const int lg = it >> 3, sub = it & 7;
        p0_transpose_item(ARG_IN(10) + (size_t)lg * 16384, 128, 128, F.PWT() + (size_t)lg * 16384, 0, nullptr, scr, sub, F.lane); }
    { gcf32 sw = ARG_IN(8); const int gt = F.bid * (NWAVES * 64) + F.tid, NT = F.G * NWAVES * 64;
      for (int i = gt; i < DEPTH * 4 * 128 * 128 / 4; i += NT) { const f32x4 v = *(const GAS f32x4*)(sw + (size_t)i * 4); v2u o; o.x = pk2(v.x, v.y); o.y = pk2(v.z, v.w); *(GAS v2u*)(F.SGW() + (size_t)i * 4) = o; } }
    gcf32 x = ARG_IN(0);
    for (int m = gw; m < M; m += NGW) {
        const GAS f32x4* xr = (const GAS f32x4*)(x + (size_t)m * D) + F.lane; GAS v2u* brow = (GAS v2u*)(F.XB() + (size_t)m * D) + F.lane;
        float s = 0.f;
#pragma unroll
        for (int j = 0; j < 8; ++j) { const f32x4 v = xr[64 * j]; s += (v.x * v.x + v.y * v.y) + (v.z * v.z + v.w * v.w); v2u o; o.x = pk2(v.x, v.y); o.y = pk2(v.z, v.w); brow[64 * j] = o; }
        s = wave_sum(s);
        if (F.lane < 8) F.SSQ()[(size_t)m * 8 + F.lane] = (F.lane == 0) ? s : 0.f;
    }
}

constexpr int VT_IMG = 128 * VT_PITCH;
template <int NU> __device__ __forceinline__ void mix_gating_units(Frame& F, int l, int u0, int ustride) {
    const int h = u0 & 3;
    LAS unsigned char* vT = F.lds + RING_OFF;
    {
        const int pos = F.tid >> 2, cq = F.tid & 3;
        v4u w[NU][4];
#pragma unroll
        for (int e = 0; e < NU; ++e) { gcbf zv = F.Z() + (size_t)(((u0 + e * ustride) >> 2) * 128 + pos) * ZW + 512 + h * 128 + cq * 32;
#pragma unroll
            for (int i = 0; i < 4; ++i) w[e][i] = *(const GAS v4u*)(zv + 8 * i); }
        gcf32 gn = ARG_IN(7) + l * 512 + h * 128 + cq * 32;
        f32x4 gv[8];
#pragma unroll
        for (int c4 = 0; c4 < 8; ++c4) gv[c4] = *(const GAS f32x4*)(gn + 4 * c4);
#pragma unroll
        for (int e = 0; e < NU; ++e) {
            float v[32];
#pragma unroll
            for (int i = 0; i < 4; ++i)
#pragma unroll
                for (int k = 0; k < 4; ++k) { const unsigned ww = w[e][i][k]; const f32x2 gl = pg8::gelu_pk((f32x2){bf_lo(ww), bf_hi(ww)}); v[8 * i + 2 * k] = gl.x; v[8 * i + 2 * k + 1] = gl.y; }
            float ss = 0.f;
#pragma unroll
            for (int c = 0; c < 32; ++c) ss += v[c] * v[c];
            ss += __shfl_xor(ss, 1); ss += __shfl_xor(ss, 2);
            const float rstd = __builtin_amdgcn_rsqf(ss * (1.0f / 128.0f) + pg8::RMS_EPS);
#pragma unroll
            for (int c4 = 0; c4 < 8; ++c4)
#pragma unroll
                for (int k = 0; k < 4; ++k) { const int c = 4 * c4 + k; *(LAS unsigned short*)(vT + e * VT_IMG + (cq * 32 + c) * VT_PITCH + pos * 2) = (unsigned short)f2bf(v[c] * rstd * gv[c4][k]); }
        }
    }
    __syncthreads();
    {
        const int fr = F.lane & 15, fq = F.lane >> 4, p = 16 * F.wave + fr;
        gcbf wsrow = F.SGW() + ((size_t)(l * 4 + h) * 128 + p) * 128 + 8 * fq;
        bf16x8 bfrag[4];
#pragma unroll
        for (int ks = 0; ks < 4; ++ks) bfrag[ks] = *(const GAS bf16x8*)(wsrow + 32 * ks);
        const float bias = ARG_IN(9)[(l * 4 + h) * 128 + p];
        v2u zz[NU][8];
#pragma unroll
        for (int e = 0; e < NU; ++e) { gcbf zu = F.Z() + (size_t)(((u0 + e * ustride) >> 2) * 128 + p) * ZW + h * 128 + 4 * fq;
#pragma unroll
            for (int dt = 0; dt < 8; ++dt) zz[e][dt] = *(const GAS v2u*)(zu + 16 * dt); }
#pragma unroll
        for (int e = 0; e < NU; ++e) {
            f32x4 acc[8];
#pragma unroll
            for (int dt = 0; dt < 8; ++dt) acc[dt] = (f32x4){0.f, 0.f, 0.f, 0.f};
#pragma unroll
            for (int ks = 0; ks < 4; ++ks)
#pragma unroll
                for (int dt = 0; dt < 8; ++dt) { const bf16x8 afrag = *(const LAS bf16x8*)(vT + e * VT_IMG + (16 * dt + fr) * VT_PITCH + 64 * ks + 16 * fq);
                    acc[dt] = __builtin_amdgcn_mfma_f32_16x16x32_bf16(afrag, bfrag[ks], acc[dt], 0, 0, 0); }
            gbf o = F.MIX() + (size_t)(((u0 + e * ustride) >> 2) * 128 + p) * D + h * 128 + 4 * fq;
#pragma unroll
            for (int dt = 0; dt < 8; ++dt) { const v2u z2 = zz[e][dt];
                const f32x2 a0 = pg8::gelu_pk((f32x2){bf_lo(z2.x), bf_hi(z2.x)}), a1 = pg8::gelu_pk((f32x2){bf_lo(z2.y), bf_hi(z2.y)});
                v2u wv; wv.x = pg8::cvt_pk_bf16(a0.x * (acc[dt][0] + bias), a0.y * (acc[dt][1] + bias)); wv.y = pg8::cvt_pk_bf16(a1.x * (acc[dt][2] + bias), a1.y * (acc[dt][3] + bias));
                *(GAS v2u*)(o + 16 * dt) = wv; }
        }
    }
    __syncthreads();
}

constexpr int PL_PITCH = 272, PL_IMG = 32 * PL_PITCH, PL_SLOT = 2 * PL_IMG;
static_assert(NWAVES * PL_SLOT <= LDSCTL_OFF, "pool slots fit below the LDS control words");
template <int g, int NUN> __device__ __forceinline__ void mix_pool_units(Frame& F, int l, int u0, int ustride) {
    constexpr int half = 1 << g;
    int lane = F.lane; asm volatile("" : "+v"(lane));
    const int fr = lane & 15, fq = lane >> 4;
    LAS unsigned char* slot = F.lds + RING_OFF + F.wave * PL_SLOT;
    gcbf pw = F.PWT() + (size_t)(l * 4 + g) * 16384 + 8 * fq;
    {
        v4u rv[NUN][8];
#pragma unroll
        for (int e = 0; e < NUN; ++e) { const int tok0 = ((u0 + e * ustride) >> 2) * 16, b = tok0 >> 13, s0 = tok0 & (SEQ - 1);
            gcbf zrow = F.Z() + (size_t)(b * SEQ) * ZW + 1024 + g * 128 + 8 * (lane & 15);
#pragma unroll
            for (int i = 0; i < 8; ++i) { const int pos = min(max(s0 - half + 4 * i + (lane >> 4), 0), SEQ - 1); rv[e][i] = *(const GAS v4u*)(zrow + (size_t)pos * ZW); } }
        __builtin_amdgcn_sched_barrier(0);
#pragma unroll
        for (int e = 0; e < NUN; ++e)
#pragma unroll
            for (int i = 0; i < 8; ++i) *(LAS v4u*)(slot + e * PL_IMG + (4 * i + (lane >> 4)) * PL_PITCH + (lane & 15) * 16) = rv[e][i];
    }
    bf16x8 afr[2][8];
    { gcbf pk = pw + (size_t)fr * 128; asm volatile("" : "+v"(pk));
#pragma unroll
      for (int dt = 0; dt < 8; ++dt) afr[0][dt] = *(const GAS bf16x8*)(pk + 2048 * dt); }
    f32x4 acc[NUN][8];
#pragma unroll
    for (int e = 0; e < NUN; ++e)
#pragma unroll
        for (int dt = 0; dt < 8; ++dt) acc[e][dt] = (f32x4){0.f, 0.f, 0.f, 0.f};
    LDS_WAIT(); asm volatile("" ::: "memory");
    const LAS unsigned char* rbase = slot + fr * PL_PITCH + fq * 16;
#pragma unroll
    for (int ks = 0; ks < 4; ++ks) {
        if (ks + 1 < 4) { gcbf pk = pw + (size_t)fr * 128 + 32 * (ks + 1); asm volatile("" : "+v"(pk));
#pragma unroll
            for (int dt = 0; dt < 8; ++dt) afr[(ks + 1) & 1][dt] = *(const GAS bf16x8*)(pk + 2048 * dt); }
#pragma unroll
        for (int e = 0; e < NUN; ++e) { const int tok0 = ((u0 + e * ustride) >> 2) * 16, s = (tok0 & (SEQ - 1)) + fr;
            const int lo = max(s - half, 0), hi = min(s + half, SEQ); const float inv_cnt = 1.0f / (float)(hi - lo);
            const LAS unsigned char* rb = rbase + e * PL_IMG + ks * 64;
            v4u wv[2 * half];
#pragma unroll
            for (int j = 0; j < 2 * half; ++j) wv[j] = *(const LAS v4u*)(rb + j * PL_PITCH);
            const v4u pc4 = *(const LAS v4u*)(rb + half * PL_PITCH);
            float sum[8];
#pragma unroll
            for (int k = 0; k < 8; ++k) sum[k] = 0.f;
#pragma unroll
            for (int j = 0; j < 2 * half; ++j) { const int pos = s + j - half; const float f = ((pos >= 0) && (pos < SEQ)) ? 1.0f : 0.0f; const v4u w = wv[j];
#pragma unroll
                for (int k = 0; k < 4; ++k) { sum[2 * k] += f * bf_lo(w[k]); sum[2 * k + 1] += f * bf_hi(w[k]); } }
            v4u dfr;
#pragma unroll
            for (int k = 0; k < 4; ++k) dfr[k] = pg8::cvt_pk_bf16(sum[2 * k] * inv_cnt - bf_lo(pc4[k]), sum[2 * k + 1] * inv_cnt - bf_hi(pc4[k]));
            const bf16x8 bfrag = __builtin_bit_cast(bf16x8, dfr);
#pragma unroll
            for (int dt = 0; dt < 8; ++dt) acc[e][dt] = __builtin_amdgcn_mfma_f32_16x16x32_bf16(afr[ks & 1][dt], bfrag, acc[e][dt], 0, 0, 0);
            __builtin_amdgcn_sched_barrier(0);
        }
    }
    gcf32 sc = ARG_IN(11) + l * 512 + g * 128 + 4 * fq;
    f32x4 sv[8];
#pragma unroll
    for (int dt = 0; dt < 8; ++dt) sv[dt] = *(const GAS f32x4*)(sc + 16 * dt);
#pragma unroll
    for (int e = 0; e < NUN; ++e) { const int tok = ((u0 + e * ustride) >> 2) * 16 + fr; gbf o = F.MIX() + (size_t)tok * D + 512 + g * 128 + 4 * fq;
#pragma unroll
        for (int dt = 0; dt < 8; ++dt) { v2u w; w.x = pg8::cvt_pk_bf16(acc[e][dt][0] * sv[dt].x, acc[e][dt][1] * sv[dt].y); w.y = pg8::cvt_pk_bf16(acc[e][dt][2] * sv[dt].z, acc[e][dt][3] * sv[dt].w);
            *(GAS v2u*)(o + 16 * dt) = w; } }
}
template <int NUN> __device__ __forceinline__ void mix_pool_dispatch(Frame& F, int l, int u0, int ustride) {
    const int g = u0 & 3;
    if (g == 0) mix_pool_units<0, NUN>(F, l, u0, ustride); else if (g == 1) mix_pool_units<1, NUN>(F, l, u0, ustride); else if (g == 2) mix_pool_units<2, NUN>(F, l, u0, ustride); else mix_pool_units<3, NUN>(F, l, u0, ustride);
}

__device__ __forceinline__ int na_fk(int key) { return (key & 3) | (((key >> 3) & 3) << 2); }
__device__ __forceinline__ void na_issue(gcbf zk, gcbf vth, int kr, int wave, int lane, LAS unsigned char* buf) {
#pragma unroll
    for (int e = 0; e < 2; ++e) { const int inst = 2 * wave + e;
        { const int key = 4 * inst + (lane >> 4), c = (lane & 15) ^ na_fk(key);
          __builtin_amdgcn_global_load_lds((const GAS unsigned*)(zk + (size_t)(kr * GRID_W + key) * ZW + 8 * c), (LAS unsigned*)(buf + inst * 1024), 16, 0, 0); }
        { const int d = 8 * inst + (lane >> 3), c = (lane & 7) ^ ((d >> 1) & 7);
          __builtin_amdgcn_global_load_lds((const GAS unsigned*)(vth + (size_t)d * SEQ + kr * GRID_W + 8 * c), (LAS unsigned*)(buf + 16384 + inst * 1024), 16, 0, 0); } }
}
__device__ __forceinline__ void mix_na_unit(Frame& F, int unit) {
    const int b = unit >> 8, h = (unit >> 5) & 7, rq = unit & 31;
    const int fr = F.lane & 15, fq = F.lane >> 4;
    const int r = 4 * rq + (F.wave >> 1), i0 = 2 * (F.wave & 1);
    const int sr = min(max(r - 4, 0), GRID_ROWS - 8);
    const int kr_lo = min(max(4 * rq - 4, 0), GRID_ROWS - 8), kr_hi = min(max(4 * rq - 1, 0), GRID_ROWS - 8) + 7, nsteps = kr_hi - kr_lo + 1;
    const LAS float* rpb = (const LAS float*)(F.lds + RPB_OFF) + h * (15 * 31);
    gcbf zk = F.Z() + (size_t)(b * SEQ) * ZW + 2560 + h * 128;
    gcbf vth = F.VT() + (size_t)(b * 1024 + h * 128) * SEQ;
    LAS unsigned char* nab = F.lds + RING_OFF;
    bf16x8 qf[2][4];
#pragma unroll
    for (int ii = 0; ii < 2; ++ii) { gcbf qp = F.Z() + (size_t)(b * SEQ + r * GRID_W + 16 * (i0 + ii) + fr) * ZW + 1536 + h * 128 + 8 * fq;
#pragma unroll
        for (int ks = 0; ks < 4; ++ks) qf[ii][ks] = *(const GAS bf16x8*)(qp + 32 * ks); }
    f32x4 oacc[2][8]; float mrun[2], lrun[2];
#pragma unroll
    for (int ii = 0; ii < 2; ++ii) { mrun[ii] = -1e30f; lrun[ii] = 0.f;
#pragma unroll
        for (int dt = 0; dt < 8; ++dt) oacc[ii][dt] = (f32x4){0.f, 0.f, 0.f, 0.f}; }
    __syncthreads();
    na_issue(zk, vth, kr_lo, F.wave, F.lane, nab);
    for (int t = 0; t < nsteps; ++t) {
        asm volatile("s_waitcnt vmcnt(0)" ::: "memory"); __builtin_amdgcn_s_barrier(); asm volatile("" ::: "memory");
        if (t + 1 < nsteps) na_issue(zk, vth, kr_lo + t + 1, F.wave, F.lane, nab + ((t + 1) & 1) * 32768);
        const int kr = kr_lo + t;
        if (kr >= sr && kr <= sr + 7) {
            const LAS unsigned char* kb = nab + (t & 1) * 32768; const LAS unsigned char* vb = kb + 16384;
            const LAS float* rrow = rpb + (kr - r + 7) * 31;
#pragma unroll
            for (int ii = 0; ii < 2; ++ii) {
                const int i = i0 + ii, qc = 16 * i + fr;
                const int cb = (i == 0) ? 0 : (i == 1) ? 8 : (i == 2) ? 24 : 32;
                const int cs = min(max(qc - 8, 0), GRID_W - 16);
                bf16x8 kf[2][4]; float bias[8];
#pragma unroll
                for (int hh = 0; hh < 2; ++hh) { const int kcl = cb + 8 * (fr >> 2) + (fr & 3) + 4 * hh, fk = na_fk(kcl);
#pragma unroll
                    for (int ks = 0; ks < 4; ++ks) kf[hh][ks] = *(const LAS bf16x8*)(kb + kcl * 256 + (((4 * ks + fq) ^ fk) << 4)); }
#pragma unroll
                for (int k = 0; k < 8; ++k) { const int kc = cb + 8 * fq + k; bias[k] = rrow[min(max(kc - qc + 15, 0), 30)]; }
                __builtin_amdgcn_sched_barrier(0);
#pragma unroll
                for (int k = 0; k < 8; ++k) asm volatile("" : "+v"(bias[k]));
                f32x4 sa[2];
#pragma unroll
                for (int hh = 0; hh < 2; ++hh) { f32x4 a = (f32x4){0.f, 0.f, 0.f, 0.f};
#pragma unroll
                    for (int ks = 0; ks < 4; ++ks) a = __builtin_amdgcn_mfma_f32_16x16x32_bf16(kf[hh][ks], qf[ii][ks], a, 0, 0, 0);
                    sa[hh] = a; }
                float sv[8]; float mt = -1e30f;
#pragma unroll
                for (int hh = 0; hh < 2; ++hh)
#pragma unroll
                    for (int j = 0; j < 4; ++j) { const int kc = cb + 8 * fq + 4 * hh + j; const bool ok = (kc >= cs) && (kc < cs + 16);
                        const float x = ok ? (sa[hh][j] * NA_SCALE + bias[4 * hh + j]) : -1e30f; sv[4 * hh + j] = x; mt = fmaxf(mt, x); }
                mt = fmaxf(mt, __shfl_xor(mt, 16)); mt = fmaxf(mt, __shfl_xor(mt, 32));
                const float mnew = fmaxf(mrun[ii], mt), alpha = __builtin_amdgcn_exp2f((mrun[ii] - mnew) * 1.44269504089f);
                mrun[ii] = mnew;
                float e[8], ps = 0.f;
#pragma unroll
                for (int k = 0; k < 8; ++k) { e[k] = __builtin_amdgcn_exp2f((sv[k] - mnew) * 1.44269504089f); ps += e[k]; }
                lrun[ii] = lrun[ii] * alpha + ps;
                v4u pw; pw.x = pg8::cvt_pk_bf16(e[0], e[1]); pw.y = pg8::cvt_pk_bf16(e[2], e[3]); pw.z = pg8::cvt_pk_bf16(e[4], e[5]); pw.w = pg8::cvt_pk_bf16(e[6], e[7]);
                const bf16x8 pf = __builtin_bit_cast(bf16x8, pw);
#pragma unroll
                for (int dh = 0; dh < 2; ++dh) { bf16x8 vf[4];
#pragma unroll
                    for (int dq = 0; dq < 4; ++dq) { const int d = 16 * (4 * dh + dq) + fr; vf[dq] = *(const LAS bf16x8*)(vb + d * 128 + ((((cb >> 3) + fq) ^ ((d >> 1) & 7)) << 4)); }
                    __builtin_amdgcn_sched_barrier(0);
#pragma unroll
                    for (int dq = 0; dq < 4; ++dq) oacc[ii][4 * dh + dq] = __builtin_amdgcn_mfma_f32_16x16x32_bf16(vf[dq], pf, oacc[ii][4 * dh + dq] * alpha, 0, 0, 0); }
            }
        }
    }
#pragma unroll
    for (int ii = 0; ii < 2; ++ii) { float l = lrun[ii]; l += __shfl_xor(l, 16); l += __shfl_xor(l, 32); const float inv = 1.0f / l;
        gbf op = F.MIX() + (size_t)(b * SEQ + r * GRID_W + 16 * (i0 + ii) + fr) * D + 1024 + h * 128 + 4 * fq;
#pragma unroll
        for (int dt = 0; dt < 8; ++dt) { const f32x4 o = oacc[ii][dt]; v2u w; w.x = pg8::cvt_pk_bf16(o[0] * inv, o[1] * inv); w.y = pg8::cvt_pk_bf16(o[2] * inv, o[3] * inv); *(GAS v2u*)(op + 16 * dt) = w; } }
}

__device__ __forceinline__ void mix_phase(Frame& F, int l) {
    {
        constexpr int NUNITS = (M / 128) * 4;
        if ((F.G & 3) == 0) { for (int u = F.bid; u < NUNITS; u += 2 * F.G) { if (u + F.G < NUNITS) mix_gating_units<2>(F, l, u, F.G); else mix_gating_units<1>(F, l, u, 0); } }
        else for (int u = F.bid; u < NUNITS; u += F.G) mix_gating_units<1>(F, l, u, 0);
    }
    const int gw = F.bid * NWAVES + F.wave, NGW = F.G * NWAVES;
    {
        constexpr int NUNITS = (M / 16) * 4;
        if ((NGW & 3) == 0) { for (int u = gw; u < NUNITS; u += 2 * NGW) { if (u + NGW < NUNITS) mix_pool_dispatch<2>(F, l, u, NGW); else mix_pool_dispatch<1>(F, l, u, 0); } }
        else for (int u = gw; u < NUNITS; u += NGW) mix_pool_dispatch<1>(F, l, u, 0);
    }
    __syncthreads();
    { gcf32 rp = ARG_IN(12) + (size_t)l * (8 * 15 * 31); LAS float* t = (LAS float*)(F.lds + RPB_OFF);
      for (int i = F.tid; i < 8 * 15 * 31; i += NWAVES * 64) t[i] = rp[i]; }
    for (int u = F.bid; u < BATCH * 8 * (GRID_ROWS / 4); u += F.G) mix_na_unit(F, u);
    __syncthreads();
}

#define PHASE_FRAME(F) Frame F; { unsigned z_ = 0u; asm volatile("" : "+s"(z_)); int t_ = (int)__builtin_amdgcn_mbcnt_hi(~0u, __builtin_amdgcn_mbcnt_lo(~0u, z_)) + 64 * wave_id_; asm volatile("" : "+v"(t_)); kargp a_ = (kargp)__builtin_amdgcn_kernarg_segment_ptr(); asm volatile("" : "+s"(a_)); \
    F.lds = (LAS unsigned char*)lds; F.tid = t_; F.lane = t_ & 63; F.wave = __builtin_amdgcn_readfirstlane(t_ >> 6); { int g_ = (int)gridDim.x, c_ = (int)blockIdx.x; asm volatile("" : "+s"(g_), "+s"(c_)); F.G = g_; F.bid = c_; } F.ap = a_; F.X = (GAS float*)a_->out; F.ws = (gptr)a_->ws; }
__global__ void __launch_bounds__(NWAVES * 64, 2) mega_fwd(Args args) {
    extern __shared__ __attribute__((aligned(16))) unsigned char lds[];
    const int wave_id_ = __builtin_amdgcn_readfirstlane((int)threadIdx.x >> 6);
    for (int u = threadIdx.x; u < (LDS_BYTES - LDSCTL_OFF) / 4; u += NWAVES * 64) ((LAS unsigned*)((LAS unsigned char*)lds + LDSCTL_OFF))[u] = 0u;
    __syncthreads();
    (void)xcd_barrier_post((xbp)(args.ws + WS_CTL) + CW_BAR, (volatile LAS unsigned*)((LAS unsigned char*)lds + MISC_OFF) + 8);
#define GRID_BAR() do { kargp a_ = (kargp)__builtin_amdgcn_kernarg_segment_ptr(); asm volatile("" : "+s"(a_)); XcdBarrier b_; b_.bar = (xbp)((gptr)a_->ws + WS_CTL) + CW_BAR; b_.x = xb_xcc_id(); \
        b_.st = (volatile LAS unsigned*)((LAS unsigned char*)lds + MISC_OFF) + 8; unsigned z_ = 0u; asm volatile("" : "+s"(z_)); b_.t0 = (wave_id_ == 0) && (__builtin_amdgcn_mbcnt_hi(~0u, __builtin_amdgcn_mbcnt_lo(~0u, z_)) == 0u); xcd_barrier(b_); } while (0)

    { PHASE_FRAME(F); p0_prologue(F); }
    GRID_BAR();

    for (int s = 0; s < 2 * DEPTH; ++s) {
        const int l = s >> 1, j = s & 1;
        {
            PHASE_FRAME(F); gptr wl = F.ws + WS_W + (size_t)l * LW_BYTES;
            pg8::Gemm g{F.XB(), (gcbf)(wl + (j ? LW_GU2 : LW_GU1)), M, NGU, D}; pg8::StaticOrder S; S.init(M, NGU, F.G, F.bid, 8);
            pg8::EpiGateUp E{F.ACT(), FF, pg8::RowRstdLds{F.SSQ(), (LAS float*)(F.lds + SCR_OFF)}};
            pg8::gemm_phase<pg8::EpiGateUp, pg8::StaticOrder, true, true>(F.lds + RING_OFF, g, S, E, F.tid);
        }
        GRID_BAR();
        {
            PHASE_FRAME(F); gptr wl = F.ws + WS_W + (size_t)l * LW_BYTES;
            pg8::Gemm g{F.ACT(), (gcbf)(wl + (j ? LW_D2 : LW_D1)), M, D, FF}; pg8::StaticOrder S; S.init(M, D, F.G, F.bid);
            pg8::EpiResid E{(GAS float*)nullptr, F.XB(), F.SSQ(), 0.5f, (LAS float*)(F.lds + SCR_OFF), F.tid};
            pg8::gemm_phase<pg8::EpiResid, pg8::StaticOrder, true, true, true>(F.lds + RING_OFF, g, S, E, F.tid);
        }
        GRID_BAR();
        if (j == 0) {
            {
                PHASE_FRAME(F); gptr wl = F.ws + WS_W + (size_t)l * LW_BYTES;
                pg8::Gemm g{F.XB(), (gcbf)(wl + LW_IN), M, ZW, D}; pg8::StaticOrder S; S.init(M, ZW, F.G, F.bid);
                pg8::EpiZ E{F.Z(), ZW, pg8::RowRstdLds{F.SSQ(), (LAS float*)(F.lds + SCR_OFF)}};
                pg8::gemm_phase<pg8::EpiZ, pg8::StaticOrder, true, true>(F.lds + RING_OFF, g, S, E, F.tid);
            }
            {
                PHASE_FRAME(F); gptr wl = F.ws + WS_W + (size_t)l * LW_BYTES;
                pg8::Gemm g{(gcbf)(wl + LW_IN) + (size_t)ZW * D, F.XB(), NVT, M, D}; pg8::StaticOrder S; S.init(NVT, M, F.G, F.bid);
                pg8::EpiVT E{F.VT(), F.SSQ()};
                pg8::gemm_phase<pg8::EpiVT, pg8::StaticOrder, true, true>(F.lds + RING_OFF, g, S, E, F.tid);
            }
            { PHASE_FRAME(F); p0_late_slot(F, l); }
            GRID_BAR();
            { PHASE_FRAME(F); mix_phase(F, l); }
            GRID_BAR();
            {
                PHASE_FRAME(F); gptr wl = F.ws + WS_W + (size_t)l * LW_BYTES;
                pg8::Gemm g{F.MIX(), (gcbf)(wl + LW_OUT), M, D, D}; pg8::StaticOrder S; S.init(M, D, F.G, F.bid);
                pg8::EpiResid E{(GAS float*)nullptr, F.XB(), F.SSQ(), 1.0f, (LAS float*)(F.lds + SCR_OFF), F.tid};
                pg8::gemm_phase<pg8::EpiResid, pg8::StaticOrder, true, true>(F.lds + RING_OFF, g, S, E, F.tid);
            }
            GRID_BAR();
        }
    }
    {
        PHASE_FRAME(F);
        const int gw = F.bid * NWAVES + F.wave, NGW = F.G * NWAVES;
        const GAS f32x4* gp = (const GAS f32x4*)ARG_IN(18) + 2 * F.lane;
        f32x4 gv[4][2];
#pragma unroll
        for (int jj = 0; jj < 4; ++jj) { gv[jj][0] = gp[128 * jj]; gv[jj][1] = gp[128 * jj + 1]; }
        for (int m = gw; m < M; m += NGW) { const float rs = pg8::row_rstd(F.SSQ(), m);
            const GAS pg8::u32x4* xr = (const GAS pg8::u32x4*)(F.XB() + (size_t)m * D) + F.lane; GAS f32x4* orow = (GAS f32x4*)(F.X + (size_t)m * D) + 2 * F.lane;
            pg8::u32x4 xv[4];
#pragma unroll
            for (int jj = 0; jj < 4; ++jj) xv[jj] = xr[64 * jj];
#pragma unroll
            for (int jj = 0; jj < 4; ++jj) { const pg8::u32x4 x = xv[jj]; f32x4 y0, y1;
                y0[0] = __builtin_bit_cast(float, x.x << 16); y0[1] = __builtin_bit_cast(float, x.x & 0xffff0000u); y0[2] = __builtin_bit_cast(float, x.y << 16); y0[3] = __builtin_bit_cast(float, x.y & 0xffff0000u);
                y1[0] = __builtin_bit_cast(float, x.z << 16); y1[1] = __builtin_bit_cast(float, x.z & 0xffff0000u); y1[2] = __builtin_bit_cast(float, x.w << 16); y1[3] = __builtin_bit_cast(float, x.w & 0xffff0000u);
                orow[128 * jj] = y0 * rs * gv[jj][0]; orow[128 * jj + 1] = y1 * rs * gv[jj][1]; } }
    }
}

extern "C" void kernel_launch(void* const* d_in, const int* in_sizes, int n_in, void* d_out, int out_size, void* d_ws, size_t ws_size, hipStream_t stream) {
    static int grid = 0;
    if (grid == 0) {
        if (n_in != 19 || in_sizes[0] != M * D || out_size != M * D || ws_size < WS_END) { fprintf(stderr, "kernel_launch: unexpected shapes: n_in %d in0 %d out %d ws %zu (need %zu)\n", n_in, n_in > 0 ? in_sizes[0] : -1, out_size, ws_size, (size_t)WS_END); grid = -1; return; }
        int dev = 0, cus = 0, per_cu = 0;
        if (hipGetDevice(&dev) != hipSuccess || hipDeviceGetAttribute(&cus, hipDeviceAttributeMultiprocessorCount, dev) != hipSuccess) { fprintf(stderr, "kernel_launch: device query failed\n"); grid = -1; return; }
        if (hipFuncSetAttribute((const void*)mega_fwd, hipFuncAttributeMaxDynamicSharedMemorySize, LDS_BYTES) != hipSuccess) { fprintf(stderr, "kernel_launch: hipFuncSetAttribute failed\n"); grid = -1; return; }
        if (hipOccupancyMaxActiveBlocksPerMultiprocessor(&per_cu, (const void*)mega_fwd, NWAVES * 64, LDS_BYTES) != hipSuccess || per_cu < 1)
            fprintf(stderr, "kernel_launch: note: occupancy query reports %d workgroups per CU\n", per_cu);
        (void)hipGetLastError();
        grid = cus;
    }
    if (grid < 0) return;
    if (hipMemsetAsync((char*)d_ws + WS_CTL, 0, CTL_ZERO_BYTES, stream) != hipSuccess) { fprintf(stderr, "kernel_launch: memset failed\n"); return; }
    Args a{};
    for (int i = 0; i < 19; ++i) a.in[i] = (const float*)d_in[i];
    a.out = (float*)d_out; a.ws = (unsigned char*)d_ws;
    hipLaunchKernelGGL(mega_fwd, dim3(grid), dim3(NWAVES * 64), LDS_BYTES, stream, a);
    const hipError_t le = hipPeekAtLastError();
    if (le != hipSuccess) fprintf(stderr, "kernel_launch: launch failed: %s\n", hipGetErrorName(le));
}
```

```cpp
#include <hip/hip_runtime.h>
#include <cstdio>
#include <cstdint>

namespace pg8 {
#define PG8_LAS __attribute__((address_space(3)))
#define PG8_GAS __attribute__((address_space(1)))
typedef unsigned short bf16_t;
typedef short bf16x8 __attribute__((ext_vector_type(8)));
typedef float f32x4 __attribute__((ext_vector_type(4)));
typedef float f32x2 __attribute__((ext_vector_type(2)));
typedef unsigned u32x4 __attribute__((ext_vector_type(4)));
typedef unsigned u32x2 __attribute__((ext_vector_type(2)));
constexpr int BM = 256, BK = 64, HALF = 128, HTB = HALF * BK * 2  , STAGE_BYTES = 8 * HTB, NXCD = 8, WGM = 4;

__host__ __device__ __forceinline__ int lds_byte(int r, int c) { const int st = (r >> 4) * 2 + (c >> 5), rr = r & 15, cc = c & 31, ob = rr * 64 + cc * 2; return st * 1024 + (ob ^ (((ob >> 9) & 1) << 5)); }
__host__ __device__ __forceinline__ void stage_rc(int b, int& R, int& C) { const int st = b / 1024, sb = b % 1024, swz = sb ^ (((sb >> 9) & 1) << 5); R = (st >> 1) * 16 + swz / 64; C = (st & 1) * 32 + (swz % 64) / 2; }
__host__ __device__ __forceinline__ int perm32(int rho) { const int n = rho >> 4, i = rho & 15; return 8 * (i >> 2) + 4 * n + (i & 3); }

struct Unit { int pm, pn; };
struct Gemm { const PG8_GAS bf16_t* A; const PG8_GAS bf16_t* Bt; int M, N, K; };

struct StaticOrder {
    int nM, nN, nwg, G, c, wgm;
    __host__ __device__ void init(int M, int N, int G_, int c_, int wgm_ = WGM) { nM = M / BM; nN = N / BM; nwg = nM * nN; G = G_; c = c_; wgm = wgm_; }
    __host__ __device__ bool next(int i, Unit& u) const {
        const long L = (long)i * G + c; if (L >= nwg) return false;
        int wgid = (int)L; { const int q = nwg / NXCD, r = nwg % NXCD, xcd = wgid % NXCD, off = wgid / NXCD; wgid = (xcd < r ? xcd * (q + 1) : r * (q + 1) + (xcd - r) * q) + off; }
        const int nig = wgm * nN, gid = wgid / nig, fm = gid * wgm, gsz = (nM - fm) < wgm ? (nM - fm) : wgm;
        u.pm = fm + ((wgid % nig) % gsz); u.pn = (wgid % nig) / gsz; return true;
    }
    __device__ __forceinline__ void a_ready(const Unit&) const {}
    __device__ __forceinline__ void done(const Unit&) const {}
};

__device__ __forceinline__ unsigned cvt_pk_bf16(float lo, float hi) { unsigned r; asm volatile("v_cvt_pk_bf16_f32 %0, %1, %2" : "=v"(r) : "v"(lo), "v"(hi)); return r; }
__device__ __forceinline__ f32x2 gelu_pk(f32x2 v) {
    const f32x2 av = __builtin_elementwise_abs(v), d = av * 0.2316418882f + 1.0f;
    f32x2 t; t.x = __builtin_amdgcn_rcpf(d.x); t.y = __builtin_amdgcn_rcpf(d.y);
    f32x2 q = t * 0.5307027145f + (-0.7265760135f); q = q * t + 0.7107068705f; q = q * t + (-0.142248368f); q = q * t + 0.127414796f; q = q * t;
    const f32x2 s = (v * v) * (-0.72134752044f);
    f32x2 e; e.x = __builtin_amdgcn_exp2f(s.x); e.y = __builtin_amdgcn_exp2f(s.y);
    const f32x2 m = v * (q * e), r = v - m;
    f32x2 o; o.x = v.x < 0.f ? m.x : r.x; o.y = v.y < 0.f ? m.y : r.y; return o;
}
__device__ __forceinline__ float silu_mul(float g, float u) {
    const float e = __builtin_amdgcn_exp2f(g * -1.44269504089f);
    return g * __builtin_amdgcn_rcpf(1.0f + e) * u;
}
constexpr float RMS_EPS = 1e-6f;
__device__ __forceinline__ float row_rstd(const PG8_GAS float* ssq, int row) {
    const f32x4 a = *(const PG8_GAS f32x4*)(ssq + (size_t)row * 8), b = *(const PG8_GAS f32x4*)(ssq + (size_t)row * 8 + 4);
    const float s = ((a.x + a.y) + (a.z + a.w)) + ((b.x + b.y) + (b.z + b.w));
    return __builtin_amdgcn_rsqf(s * (1.0f / 2048.0f) + RMS_EPS);
}

__device__ __forceinline__ void rows_rstd8(const PG8_GAS float* ssq, int row0, float (&rsv)[2][4]) {
    f32x4 pa[2][4], pb[2][4];
#pragma unroll
    for (int ai = 0; ai < 2; ++ai)
#pragma unroll
        for (int m = 0; m < 4; ++m) { const PG8_GAS f32x4* p = (const PG8_GAS f32x4*)(ssq + (size_t)(row0 + ai * HALF + m * 16) * 8); pa[ai][m] = p[0]; pb[ai][m] = p[1]; }
    __builtin_amdgcn_sched_barrier(0);
#pragma unroll
    for (int ai = 0; ai < 2; ++ai)
#pragma unroll
        for (int m = 0; m < 4; ++m) { const f32x4 a = pa[ai][m], b = pb[ai][m]; const float s = ((a.x + a.y) + (a.z + a.w)) + ((b.x + b.y) + (b.z + b.w));
            rsv[ai][m] = __builtin_amdgcn_rsqf(s * (1.0f / 2048.0f) + RMS_EPS); }
}
constexpr int RRL_MAX = 11;
struct RowRstdLds {
    const PG8_GAS float* ssq; PG8_LAS float* tab;
    template <class Sched> __device__ __forceinline__ void prep_all(const Sched& S, int tid) const {
        if (tid < 256) { f32x4 pa[RRL_MAX], pb[RRL_MAX];
#pragma unroll
            for (int i = 0; i < RRL_MAX; ++i) { Unit u; const bool ok = S.next(i, u); const int row = (ok ? u.pm : 0) * BM + tid; const PG8_GAS f32x4* p = (const PG8_GAS f32x4*)(ssq + (size_t)row * 8); pa[i] = p[0]; pb[i] = p[1]; }
            __builtin_amdgcn_sched_barrier(0);
#pragma unroll
            for (int i = 0; i < RRL_MAX; ++i) { const f32x4 a = pa[i], b = pb[i]; const float s = ((a.x + a.y) + (a.z + a.w)) + ((b.x + b.y) + (b.z + b.w)); tab[i * 256 + tid] = __builtin_amdgcn_rsqf(s * (1.0f / 2048.0f) + RMS_EPS); } }
    }
};

struct EpiGateUp {
    static constexpr bool PERM = true, AFTER_DRAIN = false, ROW_RSTD_LDS = true;
    PG8_GAS bf16_t* O; int ldo; RowRstdLds R;
    __device__ __forceinline__ void operator()(const f32x4 (&acc)[2][2][4][2], const Unit& u, int wr, int wc, int fr, int fq, int ui) const {
        const int row0 = u.pm * BM + wr * 64 + fr, col0 = u.pn * HALF + wc * 32 + 8 * fq;
        float rsv[2][4];
        if (ui < RRL_MAX) { const PG8_LAS float* rt = R.tab + ui * 256 + wr * 64 + fr;
#pragma unroll
            for (int ai = 0; ai < 2; ++ai)
#pragma unroll
                for (int m = 0; m < 4; ++m) rsv[ai][m] = rt[ai * HALF + m * 16]; }
        else rows_rstd8(R.ssq, row0, rsv);
#pragma unroll
        for (int ai = 0; ai < 2; ++ai)
#pragma unroll
            for (int m = 0; m < 4; ++m) { const int row = row0 + ai * HALF + m * 16; const float rs = rsv[ai][m], rs2 = rs * rs, cg = rs * -1.44269504089f;
                u32x4 w;
#pragma unroll
                for (int n = 0; n < 2; ++n) { const f32x4 g = acc[ai][0][m][n], u = acc[ai][1][m][n]; const f32x4 a = g * cg; f32x4 e;
                    e[0] = __builtin_amdgcn_exp2f(a[0]); e[1] = __builtin_amdgcn_exp2f(a[1]); e[2] = __builtin_amdgcn_exp2f(a[2]); e[3] = __builtin_amdgcn_exp2f(a[3]);
                    const f32x4 d = e + 1.0f; f32x4 r;
                    r[0] = __builtin_amdgcn_rcpf(d[0]); r[1] = __builtin_amdgcn_rcpf(d[1]); r[2] = __builtin_amdgcn_rcpf(d[2]); r[3] = __builtin_amdgcn_rcpf(d[3]);
                    const f32x4 o = ((g * u) * rs2) * r;
                    if (n == 0) { w.x = cvt_pk_bf16(o[0], o[1]); w.y = cvt_pk_bf16(o[2], o[3]); } else { w.z = cvt_pk_bf16(o[0], o[1]); w.w = cvt_pk_bf16(o[2], o[3]); } }
                *(PG8_GAS u32x4*)(O + (size_t)row * ldo + col0) = w; }
    }
};
struct EpiZ {
    static constexpr bool PERM = true, AFTER_DRAIN = false, ROW_RSTD_LDS = true;
    PG8_GAS bf16_t* O; int ldo; RowRstdLds R;
    __device__ __forceinline__ void operator()(const f32x4 (&acc)[2][2][4][2], const Unit& u, int wr, int wc, int fr, int fq, int ui) const {
        const int row0 = u.pm * BM + wr * 64 + fr, col0 = u.pn * BM + wc * 32 + 8 * fq;
        float rsv[2][4];
        if (ui < RRL_MAX) { const PG8_LAS float* rt = R.tab + ui * 256 + wr * 64 + fr;
#pragma unroll
            for (int ai = 0; ai < 2; ++ai)
#pragma unroll
                for (int m = 0; m < 4; ++m) rsv[ai][m] = rt[ai * HALF + m * 16]; }
        else rows_rstd8(R.ssq, row0, rsv);
#pragma unroll
        for (int ai = 0; ai < 2; ++ai)
#pragma unroll
            for (int m = 0; m < 4; ++m) { const int row = row0 + ai * HALF + m * 16; const float rs = rsv[ai][m]; PG8_GAS bf16_t* rowp = O + (size_t)row * ldo + col0;
#pragma unroll
                for (int bj = 0; bj < 2; ++bj) { const f32x4 v0 = acc[ai][bj][m][0] * rs, v1 = acc[ai][bj][m][1] * rs;
                    u32x4 w; w.x = cvt_pk_bf16(v0[0], v0[1]); w.y = cvt_pk_bf16(v0[2], v0[3]); w.z = cvt_pk_bf16(v1[0], v1[1]); w.w = cvt_pk_bf16(v1[2], v1[3]);
                    *(PG8_GAS u32x4*)(rowp + bj * HALF) = w; } }
    }
};
struct EpiVT {
    static constexpr bool PERM = true, AFTER_DRAIN = false, ROW_RSTD_LDS = false;
    PG8_GAS bf16_t* O; const PG8_GAS float* ssq;
    __device__ __forceinline__ void operator()(const f32x4 (&acc)[2][2][4][2], const Unit& u, int wr, int wc, int fr, int fq) const {
        const int row0 = u.pm * BM + wr * 64 + fr, tok0 = u.pn * BM + wc * 32 + 8 * fq;
        const int b = tok0 >> 13, s0 = tok0 & 8191;
#pragma unroll
        for (int bj = 0; bj < 2; ++bj) { float rs[8];
            { f32x4 pa[8], pb[8];
#pragma unroll
              for (int j = 0; j < 8; ++j) { const PG8_GAS f32x4* p = (const PG8_GAS f32x4*)(ssq + (size_t)(tok0 + bj * HALF + j) * 8); pa[j] = p[0]; pb[j] = p[1]; }
              __builtin_amdgcn_sched_barrier(0);
#pragma unroll
              for (int j = 0; j < 8; ++j) { const f32x4 a = pa[j], b = pb[j]; const float s = ((a.x + a.y) + (a.z + a.w)) + ((b.x + b.y) + (b.z + b.w)); rs[j] = __builtin_amdgcn_rsqf(s * (1.0f / 2048.0f) + RMS_EPS); } }
#pragma unroll
            for (int ai = 0; ai < 2; ++ai)
#pragma unroll
                for (int m = 0; m < 4; ++m) { const int n = row0 + ai * HALF + m * 16; const f32x4 v0 = acc[ai][bj][m][0], v1 = acc[ai][bj][m][1];
                    u32x4 w; w.x = cvt_pk_bf16(v0[0] * rs[0], v0[1] * rs[1]); w.y = cvt_pk_bf16(v0[2] * rs[2], v0[3] * rs[3]); w.z = cvt_pk_bf16(v1[0] * rs[4], v1[1] * rs[5]); w.w = cvt_pk_bf16(v1[2] * rs[6], v1[3] * rs[7]);
                    *(PG8_GAS u32x4*)(O + ((size_t)(b * 1024 + n) * 8192 + s0 + bj * HALF)) = w; } }
    }
};
struct EpiResid {
    static constexpr bool PERM = true, AFTER_DRAIN = false, ROW_RSTD_LDS = false;
    PG8_GAS float* Xf; PG8_GAS bf16_t* XB; PG8_GAS float* ssq; float scale; PG8_LAS float* scr; int tid;
    __device__ __forceinline__ void operator()(const f32x4 (&acc)[2][2][4][2], const Unit& u, int wr, int wc, int fr, int fq) const {
        const int row0 = u.pm * BM + wr * 64 + fr, col0 = u.pn * BM + wc * 32 + 8 * fq;
        PG8_GAS bf16_t* bp0 = XB + (size_t)row0 * 2048 + col0;
        u32x4 xo[2][4][2];
#pragma unroll
        for (int ai = 0; ai < 2; ++ai)
#pragma unroll
            for (int m = 0; m < 4; ++m)
#pragma unroll
                for (int bj = 0; bj < 2; ++bj) xo[ai][m][bj] = *(const PG8_GAS u32x4*)(bp0 + (size_t)(ai * HALF + m * 16) * 2048 + bj * HALF);
        float ssv[2][4];
#pragma unroll
        for (int ai = 0; ai < 2; ++ai)
#pragma unroll
            for (int m = 0; m < 4; ++m) { float ss = 0.f;
#pragma unroll
                for (int bj = 0; bj < 2; ++bj) { const u32x4 x = xo[ai][m][bj];
                    f32x4 y0, y1;
                    y0[0] = __builtin_bit_cast(float, x.x << 16) + acc[ai][bj][m][0][0] * scale; y0[1] = __builtin_bit_cast(float, x.x & 0xffff0000u) + acc[ai][bj][m][0][1] * scale;
                    y0[2] = __builtin_bit_cast(float, x.y << 16) + acc[ai][bj][m][0][2] * scale; y0[3] = __builtin_bit_cast(float, x.y & 0xffff0000u) + acc[ai][bj][m][0][3] * scale;
                    y1[0] = __builtin_bit_cast(float, x.z << 16) + acc[ai][bj][m][1][0] * scale; y1[1] = __builtin_bit_cast(float, x.z & 0xffff0000u) + acc[ai][bj][m][1][1] * scale;
                    y1[2] = __builtin_bit_cast(float, x.w << 16) + acc[ai][bj][m][1][2] * scale; y1[3] = __builtin_bit_cast(float, x.w & 0xffff0000u) + acc[ai][bj][m][1][3] * scale;
                    u32x4 w; w.x = cvt_pk_bf16(y0[0], y0[1]); w.y = cvt_pk_bf16(y0[2], y0[3]); w.z = cvt_pk_bf16(y1[0], y1[1]); w.w = cvt_pk_bf16(y1[2], y1[3]);
                    *(PG8_GAS u32x4*)(bp0 + (size_t)(ai * HALF + m * 16) * 2048 + bj * HALF) = w;
                    ss += ((y0[0] * y0[0] + y0[1] * y0[1]) + (y0[2] * y0[2] + y0[3] * y0[3])) + ((y1[0] * y1[0] + y1[1] * y1[1]) + (y1[2] * y1[2] + y1[3] * y1[3])); }
                ssv[ai][m] = ss; }
        { float t[2][4];
#pragma unroll
          for (int ai = 0; ai < 2; ++ai)
#pragma unroll
              for (int m = 0; m < 4; ++m) t[ai][m] = __shfl_xor(ssv[ai][m], 16);
#pragma unroll
          for (int ai = 0; ai < 2; ++ai)
#pragma unroll
              for (int m = 0; m < 4; ++m) ssv[ai][m] += t[ai][m];
#pragma unroll
          for (int ai = 0; ai < 2; ++ai)
#pragma unroll
              for (int m = 0; m < 4; ++m) t[ai][m] = __shfl_xor(ssv[ai][m], 32);
#pragma unroll
          for (int ai = 0; ai < 2; ++ai)
#pragma unroll
              for (int m = 0; m < 4; ++m) { if (fq == 0) scr[(ai * HALF + wr * 64 + m * 16 + fr) * 4 + wc] = ssv[ai][m] + t[ai][m]; } }
        if (Xf) {
            PG8_GAS float* xp0 = Xf + (size_t)row0 * 2048 + col0;
#pragma unroll
            for (int ai = 0; ai < 2; ++ai)
#pragma unroll
                for (int m = 0; m < 4; ++m)
#pragma unroll
                    for (int bj = 0; bj < 2; ++bj) { const u32x4 x = xo[ai][m][bj];
                        f32x4 y0, y1;
                        y0[0] = __builtin_bit_cast(float, x.x << 16) + acc[ai][bj][m][0][0] * scale; y0[1] = __builtin_bit_cast(float, x.x & 0xffff0000u) + acc[ai][bj][m][0][1] * scale;
                        y0[2] = __builtin_bit_cast(float, x.y << 16) + acc[ai][bj][m][0][2] * scale; y0[3] = __builtin_bit_cast(float, x.y & 0xffff0000u) + acc[ai][bj][m][0][3] * scale;
                        y1[0] = __builtin_bit_cast(float, x.z << 16) + acc[ai][bj][m][1][0] * scale; y1[1] = __builtin_bit_cast(float, x.z & 0xffff0000u) + acc[ai][bj][m][1][1] * scale;
                        y1[2] = __builtin_bit_cast(float, x.w << 16) + acc[ai][bj][m][1][2] * scale; y1[3] = __builtin_bit_cast(float, x.w & 0xffff0000u) + acc[ai][bj][m][1][3] * scale;
                        PG8_GAS float* xp = xp0 + (size_t)(ai * HALF + m * 16) * 2048 + bj * HALF; *(PG8_GAS f32x4*)xp = y0; *(PG8_GAS f32x4*)(xp + 4) = y1; }
        }
        asm volatile("s_waitcnt lgkmcnt(0)" ::: "memory"); __builtin_amdgcn_s_barrier(); asm volatile("" ::: "memory");
        if (tid < 256) { const f32x4 p = *(const PG8_LAS f32x4*)(scr + tid * 4); ssq[(size_t)(u.pm * BM + tid) * 8 + u.pn] = (p.x + p.y) + (p.z + p.w); }
    }
};

template <class Epi, class Sched, bool ALIGN_EPI = false, bool SP2 = false, bool KREV = false>
__device__ __forceinline__ void gemm_phase(PG8_LAS unsigned char* lds, const Gemm g, const Sched& S, const Epi& E, int tid_in) {
    int tid_ = tid_in; asm volatile("" : "+v"(tid_));
    const int tid = tid_, wid = __builtin_amdgcn_readfirstlane(tid >> 6), lane = tid & 63, wr = wid >> 2, wc = wid & 3, fr = lane & 15, fq = lane >> 4;
    const int K = g.K, nt = K / BK;
    unsigned voffA[2], voffB[2];
#pragma unroll
    for (int i = 0; i < 2; ++i) { int R, C; stage_rc(tid * 16 + i * 8192, R, C); const int Rb = Epi::PERM ? ((R & ~31) + perm32(R & 31)) : R;
        voffA[i] = (unsigned)(R * K + C) * 2u; voffB[i] = (unsigned)(Rb * K + C) * 2u; }
    const ptrdiff_t kstep = KREV ? -(ptrdiff_t)(BK * 2) : (ptrdiff_t)(BK * 2);
    const size_t hstep = (size_t)HALF * K * 2;
    const size_t tstep = 2 * hstep;
    const unsigned ldsw = (unsigned)wid * 1024u;
    const int aoff = lds_byte(wr * 64 + fr, fq * 8), boff = lds_byte(wc * 32 + fr, fq * 8);
#define PG8_SA(b, h) (((b) * 2 + (h)) * HTB)
#define PG8_SB(b, h) ((4 + (b) * 2 + (h)) * HTB)
#define PG8_STAGE(bufoff, gbase, voff) do { _Pragma("unroll") for (int _i = 0; _i < 2; ++_i) \
        __builtin_amdgcn_global_load_lds((const PG8_GAS unsigned*)((const PG8_GAS char*)(gbase) + (voff)[_i]), (PG8_LAS unsigned*)(lds + (bufoff) + ldsw + _i * 8192), 16, 0, 0); } while (0)
#define PG8_LDA(dst, b, h) do { _Pragma("unroll") for (int m = 0; m < 4; ++m) _Pragma("unroll") for (int k = 0; k < 2; ++k) dst[m][k] = *(const PG8_LAS bf16x8*)(lds + PG8_SA(b, h) + aoff + m * 2048 + k * 1024); } while (0)
#define PG8_LDB(dst, b, h) do { _Pragma("unroll") for (int n = 0; n < 2; ++n) _Pragma("unroll") for (int k = 0; k < 2; ++k) dst[n][k] = *(const PG8_LAS bf16x8*)(lds + PG8_SB(b, h) + boff + n * 2048 + k * 1024); } while (0)
#define PG8_MMA(ai, bj, At, Bt) do { __builtin_amdgcn_s_setprio(1); _Pragma("unroll") for (int m = 0; m < 4; ++m) _Pragma("unroll") for (int n = 0; n < 2; ++n) _Pragma("unroll") for (int k = 0; k < 2; ++k) \
        acc[ai][bj][m][n] = __builtin_amdgcn_mfma_f32_16x16x32_bf16(Bt[n][k], At[m][k], acc[ai][bj][m][n], 0, 0, 0); __builtin_amdgcn_s_setprio(0); } while (0)
#define PG8_WAIT_V(n) asm volatile("s_waitcnt vmcnt(" #n ")" ::: "memory")
#define PG8_WAIT_L(n) asm volatile("s_waitcnt lgkmcnt(" #n ")" ::: "memory")
#define PG8_BAR __builtin_amdgcn_s_barrier()
#define PG8_SCHED __builtin_amdgcn_sched_barrier(0)
    Unit cur, nxt; int ui = 0;
    if (!S.next(0, cur)) return;
    f32x4 acc[2][2][4][2];
#pragma unroll
    for (int a = 0; a < 2; ++a)
#pragma unroll
        for (int b = 0; b < 2; ++b)
#pragma unroll
            for (int m = 0; m < 4; ++m)
#pragma unroll
                for (int n = 0; n < 2; ++n) acc[a][b][m][n] = (f32x4){0.f, 0.f, 0.f, 0.f};
    bf16x8 At[4][2], B0[2][2], B1[2][2];
    const size_t k0off = KREV ? (size_t)(nt - 1) * (size_t)(BK * 2) : (size_t)0;
    const PG8_GAS char* cA = (const PG8_GAS char*)g.A + (size_t)cur.pm * tstep + k0off; const PG8_GAS char* cB = (const PG8_GAS char*)g.Bt + (size_t)cur.pn * tstep + k0off;
    S.a_ready(cur);
    if constexpr (Epi::ROW_RSTD_LDS) E.R.prep_all(S, tid);
    if constexpr (SP2) {
        PG8_STAGE(PG8_SB(0, 0), cB, voffB); PG8_STAGE(PG8_SB(0, 1), cB + hstep, voffB); PG8_STAGE(PG8_SA(0, 0), cA, voffA); PG8_STAGE(PG8_SA(0, 1), cA + hstep, voffA);
        if (wr == 1) PG8_BAR;
        PG8_WAIT_V(2); PG8_BAR;
        PG8_STAGE(PG8_SB(1, 0), cB + kstep, voffB); PG8_STAGE(PG8_SA(1, 0), cA + kstep, voffA); PG8_STAGE(PG8_SB(1, 1), cB + hstep + kstep, voffB);
        PG8_WAIT_V(6); PG8_BAR;
    } else {
        PG8_STAGE(PG8_SB(0, 0), cB, voffB); PG8_STAGE(PG8_SA(0, 0), cA, voffA); PG8_STAGE(PG8_SB(0, 1), cB + hstep, voffB); PG8_STAGE(PG8_SA(0, 1), cA + hstep, voffA);
        if (wr == 1) PG8_BAR;
        PG8_WAIT_V(4); PG8_BAR;
        PG8_STAGE(PG8_SB(1, 0), cB + kstep, voffB); PG8_STAGE(PG8_SA(1, 0), cA + kstep, voffA); PG8_STAGE(PG8_SB(1, 1), cB + hstep + kstep, voffB);
        PG8_WAIT_V(6); PG8_BAR;
    }
    for (;;) {
        const bool has_next = S.next(ui + 1, nxt);
        const PG8_GAS char* nA = has_next ? (const PG8_GAS char*)g.A + (size_t)nxt.pm * tstep + k0off : cA; const PG8_GAS char* nB = has_next ? (const PG8_GAS char*)g.Bt + (size_t)nxt.pn * tstep + k0off : cB;
        for (int t = 0; t < nt; t += 2) {
            const bool last = (t == nt - 2);
            const PG8_GAS char* a1 = cA + (ptrdiff_t)(t + 1) * kstep;
            const PG8_GAS char* a2 = last ? nA : cA + (ptrdiff_t)(t + 2) * kstep; const PG8_GAS char* b2 = last ? nB : cB + (ptrdiff_t)(t + 2) * kstep;
            const PG8_GAS char* a3 = a2 + kstep; const PG8_GAS char* b3 = b2 + kstep;
            if (last && has_next) S.a_ready(nxt);
            if constexpr (SP2) {
            PG8_LDB(B0, 0, 0); PG8_LDB(B1, 0, 1); PG8_SCHED; PG8_LDA(At, 0, 0); PG8_STAGE(PG8_SA(1, 1), a1 + hstep, voffA);
            PG8_WAIT_V(8); PG8_WAIT_L(0); PG8_BAR; PG8_MMA(0, 0, At, B0); PG8_MMA(0, 1, At, B1); PG8_BAR; PG8_SCHED;
            PG8_LDA(At, 0, 1); PG8_STAGE(PG8_SB(0, 0), b2, voffB); PG8_STAGE(PG8_SB(0, 1), b2 + hstep, voffB); PG8_STAGE(PG8_SA(0, 0), a2, voffA);
            PG8_WAIT_V(8); PG8_WAIT_L(0); PG8_BAR; PG8_MMA(1, 0, At, B0); PG8_MMA(1, 1, At, B1); PG8_BAR; PG8_SCHED;
            PG8_LDB(B0, 1, 0); PG8_LDB(B1, 1, 1); PG8_SCHED; PG8_LDA(At, 1, 0); PG8_STAGE(PG8_SA(0, 1), a2 + hstep, voffA);
            PG8_WAIT_V(8); PG8_WAIT_L(0); PG8_BAR; PG8_MMA(0, 0, At, B0); PG8_MMA(0, 1, At, B1); PG8_BAR; PG8_SCHED;
            PG8_LDA(At, 1, 1); PG8_STAGE(PG8_SB(1, 0), b3, voffB); PG8_STAGE(PG8_SB(1, 1), b3 + hstep, voffB); PG8_STAGE(PG8_SA(1, 0), a3, voffA);
            PG8_WAIT_V(8); PG8_WAIT_L(0); PG8_BAR; PG8_MMA(1, 0, At, B0); PG8_MMA(1, 1, At, B1); PG8_BAR; PG8_SCHED;
            } else {
            PG8_LDB(B0, 0, 0); PG8_SCHED; PG8_LDA(At, 0, 0); PG8_STAGE(PG8_SA(1, 1), a1 + hstep, voffA);
            PG8_WAIT_L(8); PG8_BAR; PG8_WAIT_L(0); PG8_MMA(0, 0, At, B0); PG8_BAR; PG8_SCHED;
            PG8_LDB(B1, 0, 1); PG8_STAGE(PG8_SB(0, 0), b2, voffB);
            PG8_BAR; PG8_WAIT_L(0); PG8_MMA(0, 1, At, B1); PG8_BAR;
            PG8_LDA(At, 0, 1); PG8_STAGE(PG8_SA(0, 0), a2, voffA);
            PG8_BAR; PG8_WAIT_L(0); PG8_MMA(1, 0, At, B0); PG8_BAR; PG8_SCHED;
            PG8_STAGE(PG8_SB(0, 1), b2 + hstep, voffB);
            PG8_WAIT_V(6); PG8_BAR; PG8_MMA(1, 1, At, B1); PG8_BAR;
            PG8_LDB(B0, 1, 0); PG8_SCHED; PG8_LDA(At, 1, 0); PG8_STAGE(PG8_SA(0, 1), a2 + hstep, voffA);
            PG8_WAIT_L(8); PG8_BAR; PG8_WAIT_L(0); PG8_MMA(0, 0, At, B0); PG8_BAR; PG8_SCHED;
            PG8_LDB(B1, 1, 1); PG8_STAGE(PG8_SB(1, 0), b3, voffB);
            PG8_BAR; PG8_WAIT_L(0); PG8_MMA(0, 1, At, B1); PG8_BAR;
            PG8_LDA(At, 1, 1); PG8_STAGE(PG8_SA(1, 0), a3, voffA);
            PG8_BAR; PG8_WAIT_L(0); PG8_MMA(1, 0, At, B0); PG8_BAR; PG8_SCHED;
            PG8_STAGE(PG8_SB(1, 1), b3 + hstep, voffB);
            PG8_WAIT_V(6); PG8_BAR; PG8_MMA(1, 1, At, B1); PG8_BAR;
            }
        }
        if constexpr (ALIGN_EPI) { if (wr == 0) PG8_BAR; }
        if constexpr (!Epi::AFTER_DRAIN) { if constexpr (Epi::ROW_RSTD_LDS) E(acc, cur, wr, wc, fr, fq, ui); else E(acc, cur, wr, wc, fr, fq); S.done(cur); }
        if (!has_next) break;
#pragma unroll
        for (int a = 0; a < 2; ++a)
#pragma unroll
            for (int b = 0; b < 2; ++b)
#pragma unroll
                for (int m = 0; m < 4; ++m)
#pragma unroll
                    for (int n = 0; n < 2; ++n) acc[a][b][m][n] = (f32x4){0.f, 0.f, 0.f, 0.f};
        cur = nxt; cA = nA; cB = nB; ++ui;
        if constexpr (ALIGN_EPI) { if (wr == 1) PG8_BAR; }
    }
    PG8_WAIT_V(0);
    if constexpr (!ALIGN_EPI) { if (wr == 0) PG8_BAR; }
    PG8_BAR;
#undef PG8_SA
#undef PG8_SB
#undef PG8_STAGE
#undef PG8_LDA
#undef PG8_LDB
#undef PG8_MMA
#undef PG8_WAIT_V
#undef PG8_WAIT_L
#undef PG8_BAR
#undef PG8_SCHED
}
}

constexpr int NWAVES = 8;
constexpr int DEPTH = 4, BATCH = 2, SEQ = 8192, D = 2048, FF = 5632, NGU = 2 * FF, INC = 4608, ZW = 3584, NVT = 1024;
constexpr int M = BATCH * SEQ;
constexpr int GRID_W = 64, GRID_ROWS = SEQ / GRID_W;
constexpr float NA_SCALE = 0.08838834764831845f;

constexpr size_t MiB = 1u << 20;
constexpr size_t WS_CTL = 0, CTL_ZERO_BYTES = 1 * MiB;
constexpr size_t WS_SSQ = 1 * MiB;
constexpr size_t WS_SGW = 2 * MiB;
constexpr size_t WS_PWT = 3 * MiB;
constexpr size_t WS_W = 4 * MiB;
constexpr size_t LW_GU1 = 0, LW_D1 = 44 * MiB, LW_IN = 66 * MiB, LW_OUT = 84 * MiB, LW_GU2 = 92 * MiB, LW_D2 = 136 * MiB, LW_BYTES = 158 * MiB;
constexpr size_t WS_XB = WS_W + DEPTH * LW_BYTES;
constexpr size_t WS_ACT = WS_XB + 64 * MiB;
constexpr size_t WS_Z = WS_ACT + 176 * MiB;
constexpr size_t WS_VT = WS_Z + 112 * MiB;
constexpr size_t WS_MIX = WS_VT + 32 * MiB;
constexpr size_t WS_END = WS_MIX + 64 * MiB;
static_assert((size_t)NGU * D * 2 == 44 * MiB && (size_t)D * FF * 2 == 22 * MiB && (size_t)INC * D * 2 == 18 * MiB && (size_t)D * D * 2 == 8 * MiB, "weight sizes");
static_assert((size_t)M * FF * 2 == 176 * MiB && (size_t)M * ZW * 2 == 112 * MiB, "activation sizes");
constexpr int CW_BAR = 4096;

constexpr int RING_OFF = 0, RING_BYTES = 131072;
constexpr int SCR_OFF = RING_BYTES;
constexpr int LDSCTL_OFF = SCR_OFF + 16384, MISC_OFF = LDSCTL_OFF + 320;
constexpr int LDS_BYTES = LDSCTL_OFF + 1024;
static_assert(pg8::RRL_MAX * 1024 <= 16384 && LDS_BYTES <= 163840, "LDS scratch");
static_assert(MISC_OFF + 128 <= LDS_BYTES, "LDS map");
constexpr int VT_PITCH = 272;
constexpr int RPB_OFF = 98304;

#define GAS __attribute__((address_space(1)))
#define LAS __attribute__((address_space(3)))
typedef unsigned short bf16;
typedef unsigned v4u __attribute__((ext_vector_type(4)));
typedef unsigned v2u __attribute__((ext_vector_type(2)));
typedef float f32x4 __attribute__((ext_vector_type(4)));
typedef float f32x2 __attribute__((ext_vector_type(2)));
typedef short bf16x8 __attribute__((ext_vector_type(8)));
typedef GAS unsigned gu32;
#define RLX_AGENT __ATOMIC_RELAXED, __HIP_MEMORY_SCOPE_AGENT
#define LDS_WAIT() asm volatile("s_waitcnt lgkmcnt(0)" ::: "memory")
#define VM_WAIT() asm volatile("s_waitcnt vmcnt(0)" ::: "memory")
__device__ __forceinline__ unsigned f2bf(float f) { unsigned u = __builtin_bit_cast(unsigned, f); return (u + 0x7fffu + ((u >> 16) & 1u)) >> 16; }
__device__ __forceinline__ unsigned pk2(float lo, float hi) { return f2bf(lo) | (f2bf(hi) << 16); }
__device__ __forceinline__ float bf_lo(unsigned w) { return __builtin_bit_cast(float, w << 16); }
__device__ __forceinline__ float bf_hi(unsigned w) { return __builtin_bit_cast(float, w & 0xffff0000u); }

#define XB_TMO      128
#define XB_XCNT(j)  (256  + 64 * (j))
#define XB_XSUB(j)  (1280 + 64 * (j))
#define XB_XGEN(j)  (2304 + 64 * (j))
#define XB_TOP      3328
#define XB_TOPGEN   3392
#define XCD_BAR_WORDS 3456
#define XB_SPIN_CAP (1u << 18)

typedef GAS unsigned* xbp;
__device__ __forceinline__ unsigned xb_ld(xbp p)              { return __hip_atomic_load(p, __ATOMIC_RELAXED, __HIP_MEMORY_SCOPE_AGENT); }
__device__ __forceinline__ unsigned xb_add(xbp p, unsigned v) { return __hip_atomic_fetch_add(p, v, __ATOMIC_RELAXED, __HIP_MEMORY_SCOPE_AGENT); }
__device__ __forceinline__ unsigned xb_xcc_id() { return (unsigned)__builtin_amdgcn_s_getreg((3 << 11) | 20) & 0xFu; }
#define XB_SPIN(cond, bar) do { unsigned _sp = 0; while (cond) { __builtin_amdgcn_s_sleep(1); \
    if ((++_sp & 255u) == 0u) { if (xb_ld(&(bar)[XB_TMO])) break; if (_sp > XB_SPIN_CAP) { xb_add(&(bar)[XB_TMO], 1u); break; } } } } while (0)

struct XcdBarrier {
    xbp bar; unsigned x;
    volatile LAS unsigned* st;
    bool t0;
};
__device__ __forceinline__ XcdBarrier xcd_barrier_post(xbp bar, volatile LAS unsigned* st) {
    XcdBarrier b; b.bar = bar; b.x = xb_xcc_id(); b.st = st; b.t0 = (threadIdx.x == 0);
    if (b.t0) (void)xb_add(&bar[XB_XCNT(b.x)], 1u);
    return b;
}
__device__ __forceinline__ void xcd_barrier_complete(xbp bar, unsigned x, unsigned& nloc, unsigned& nx) {
    const unsigned G = gridDim.x * gridDim.y * gridDim.z;
    unsigned sum, cnt, mine, sp = 0u;
    for (;;) {
        sum = 0u; cnt = 0u; mine = 0u;
#pragma unroll
        for (unsigned j = 0; j < 16; ++j) { const unsigned c = xb_ld(&bar[XB_XCNT(j)]); sum += c; cnt += (c > 0u) ? 1u : 0u; mine = (j == x) ? c : mine; }
        if (sum == G) break;
        __builtin_amdgcn_s_sleep(1);
        if ((++sp & 255u) == 0u) { if (xb_ld(&bar[XB_TMO])) break; if (sp > XB_SPIN_CAP) { xb_add(&bar[XB_TMO], 1u); break; } }
    }
    nloc = mine > 0u ? mine : 1u; nx = cnt > 0u ? cnt : 1u;
}
__device__ __forceinline__ void xcd_barrier(const XcdBarrier& b) {
    asm volatile("s_waitcnt vmcnt(0)" ::: "memory");
    __syncthreads();
    if (b.t0) {
        xbp bar = b.bar;
        __builtin_amdgcn_s_waitcnt(0);
        unsigned nloc = b.st[0], nx = b.st[1];
        if (nloc == 0u) { xcd_barrier_complete(bar, b.x, nloc, nx); b.st[0] = nloc; b.st[1] = nx; }
        const unsigned old = xb_add(&bar[XB_XSUB(b.x)], 1u);
        const unsigned gen = old / nloc;
        if (old + 1u == (gen + 1u) * nloc) {
            __builtin_amdgcn_fence(__ATOMIC_RELEASE, "agent");
            asm volatile("s_waitcnt vmcnt(0)" ::: "memory");
            const unsigned og = xb_add(&bar[XB_TOP], 1u);
            const unsigned tg = og / nx;
            if (og + 1u == (tg + 1u) * nx) xb_add(&bar[XB_TOPGEN], 1u);
            else XB_SPIN(xb_ld(&bar[XB_TOPGEN]) == tg, bar);
            __builtin_amdgcn_fence(__ATOMIC_ACQUIRE, "agent");
            xb_add(&bar[XB_XGEN(b.x)], 1u);
            asm volatile("s_waitcnt vmcnt(0)" ::: "memory");
        } else {
            XB_SPIN(xb_ld(&bar[XB_XGEN(b.x)]) == gen, bar);
            __builtin_amdgcn_fence(__ATOMIC_ACQUIRE, "agent");
            asm volatile("s_waitcnt vmcnt(0)" ::: "memory");
        }
    }
    __syncthreads();
}

typedef GAS unsigned char* gptr;
typedef const GAS float* gcf32;
typedef GAS bf16* gbf;
typedef const GAS bf16* gcbf;
struct Args { const float* in[19]; float* out; unsigned char* ws; };
typedef const __attribute__((address_space(4))) Args* kargp;
struct Frame {
    LAS unsigned char* lds;
    int tid, lane, wave;
    int G, bid;
    GAS float* X;
    gptr ws;
    kargp ap;
    __device__ __forceinline__ gbf XB() const { return (gbf)(ws + WS_XB); }
    __device__ __forceinline__ gbf ACT() const { return (gbf)(ws + WS_ACT); }
    __device__ __forceinline__ gbf Z() const { return (gbf)(ws + WS_Z); }
    __device__ __forceinline__ gbf VT() const { return (gbf)(ws + WS_VT); }
    __device__ __forceinline__ gbf MIX() const { return (gbf)(ws + WS_MIX); }
    __device__ __forceinline__ gbf SGW() const { return (gbf)(ws + WS_SGW); }
    __device__ __forceinline__ gbf PWT() const { return (gbf)(ws + WS_PWT); }
    __device__ __forceinline__ GAS float* SSQ() const { return (GAS float*)(ws + WS_SSQ); }
};
#define ARG_IN(k) ((gcf32)F.ap->in[k])

__device__ __forceinline__ float wave_sum(float v) {
#pragma unroll
    for (int o = 1; o < 64; o <<= 1) v += __shfl_xor(v, o);
    return v;
}

__device__ __forceinline__ void p0_transpose_item(gcf32 W, int K, int N, gbf WT, int rowmode, gcf32 gain, LAS float* scr, int item, int lane) {
    const int nblk = N / 32, kb = item / nblk, nb = item % nblk, k0 = 64 * kb, n0 = 32 * nb;
    int rowbase = n0;
    if (rowmode == 1) rowbase = 256 * (n0 >> 7) + (n0 & 127);
    if (rowmode == 2) rowbase = 256 * (n0 >> 7) + 128 + (n0 & 127);
#pragma unroll 8
    for (int i = 0; i < 32; ++i) { const int kk = 2 * i + (lane >> 5); float v = W[(size_t)(k0 + kk) * N + n0 + (lane & 31)]; if (gain) v *= gain[k0 + kk]; scr[kk * 33 + (lane & 31)] = v; }
    LDS_WAIT(); asm volatile("" ::: "memory");
    const int c = lane & 7;
#pragma unroll
    for (int j = 0; j < 4; ++j) { const int n = (lane >> 3) + 8 * j; const LAS float* s = scr + (8 * c) * 33 + n;
        v4u o; o.x = pk2(s[0 * 33], s[1 * 33]); o.y = pk2(s[2 * 33], s[3 * 33]); o.z = pk2(s[4 * 33], s[5 * 33]); o.w = pk2(s[6 * 33], s[7 * 33]);
        *(GAS v4u*)(WT + (size_t)(rowbase + n) * K + k0 + 8 * c) = o; }
    LDS_WAIT(); asm volatile("" ::: "memory");
}

struct P0Tile { gcf32 W; gcf32 gain; gbf WT; int K, N, rowmode, k0, n0, has_gain; };
constexpr int P0_SLOT = 8192 + 256;
static_assert(NWAVES * 2 * P0_SLOT <= LDSCTL_OFF, "prologue slots fit below the LDS control words");
constexpr int P0_T_G = (D / 64) * (FF / 256), P0_T_D = (FF / 64) * (D / 256), P0_T_IN = (D / 64) * (INC / 256), P0_T_OUT = (D / 64) * (D / 256);
constexpr int P0_PER_LAYER = 4 * P0_T_G + 2 * P0_T_D + P0_T_IN + P0_T_OUT, P0_TOTAL = DEPTH * P0_PER_LAYER;
__device__ __forceinline__ void p0_tile_decode(const Frame& F, int T, P0Tile& t) {
    constexpr int T_G = P0_T_G, T_D = P0_T_D, T_IN = P0_T_IN, T_OUT = P0_T_OUT;
    const int l = T / P0_PER_LAYER; int r = T % P0_PER_LAYER;
    gptr wl = F.ws + WS_W + (size_t)l * LW_BYTES; const size_t oG = (size_t)l * D * FF;
    int nblk;
    if (r < T_G)                { t.W = ARG_IN(2) + oG;  t.gain = ARG_IN(1) + l * D;  t.WT = (gbf)(wl + LW_GU1); t.K = D;  t.N = FF;  t.rowmode = 1; }
    else if ((r -= T_G) < T_G)  { t.W = ARG_IN(3) + oG;  t.gain = ARG_IN(1) + l * D;  t.WT = (gbf)(wl + LW_GU1); t.K = D;  t.N = FF;  t.rowmode = 2; }
    else if ((r -= T_G) < T_D)  { t.W = ARG_IN(4) + oG;  t.gain = ARG_IN(4) + oG;     t.WT = (gbf)(wl + LW_D1);  t.K = FF; t.N = D;   t.rowmode = 0; }
    else if ((r -= T_D) < T_IN) { t.W = ARG_IN(6) + (size_t)l * D * INC; t.gain = ARG_IN(5) + l * D; t.WT = (gbf)(wl + LW_IN); t.K = D; t.N = INC; t.rowmode = 0; }
    else if ((r -= T_IN) < T_OUT) { t.W = ARG_IN(13) + (size_t)l * D * D; t.gain = ARG_IN(13);  t.WT = (gbf)(wl + LW_OUT); t.K = D;  t.N = D;   t.rowmode = 0; }
    else if ((r -= T_OUT) < T_G) { t.W = ARG_IN(15) + oG; t.gain = ARG_IN(14) + l * D; t.WT = (gbf)(wl + LW_GU2); t.K = D;  t.N = FF;  t.rowmode = 1; }
    else if ((r -= T_G) < T_G)  { t.W = ARG_IN(16) + oG; t.gain = ARG_IN(14) + l * D; t.WT = (gbf)(wl + LW_GU2); t.K = D;  t.N = FF;  t.rowmode = 2; }
    else { r -= T_G;              t.W = ARG_IN(17) + oG; t.gain = ARG_IN(17) + oG;    t.WT = (gbf)(wl + LW_D2);  t.K = FF; t.N = D;   t.rowmode = 0; }
    t.has_gain = (t.rowmode != 0) || (t.N == INC);
    nblk = t.N / 256; t.k0 = 64 * (r / nblk); t.n0 = 256 * (r % nblk);
}
__device__ __forceinline__ void p0_strip_issue(const P0Tile& t, int w, int lane, LAS unsigned char* slot) {
    gcf32 src = t.W + (size_t)(t.k0 + (lane >> 3)) * t.N + t.n0 + 32 * w;
#pragma unroll
    for (int j = 0; j < 8; ++j) __builtin_amdgcn_global_load_lds((const GAS unsigned*)(src + (size_t)(8 * j) * t.N + 4 * ((lane & 7) ^ j)), (LAS unsigned*)(slot + j * 1024), 16, 0, 0);
    __builtin_amdgcn_global_load_lds((const GAS unsigned*)(t.gain + t.k0 + lane), (LAS unsigned*)(slot + 8192), 4, 0, 0);
}
__device__ __forceinline__ void p0_strip_finish(const P0Tile& t, int w, int lane, const LAS unsigned char* slot) {
    const int k8 = lane & 7, nl = lane >> 3;
    float g[8];
    { const f32x4 ga = *(const LAS f32x4*)(slot + 8192 + 32 * k8), gb = *(const LAS f32x4*)(slot + 8192 + 32 * k8 + 16);
      g[0] = ga.x; g[1] = ga.y; g[2] = ga.z; g[3] = ga.w; g[4] = gb.x; g[5] = gb.y; g[6] = gb.z; g[7] = gb.w;
#pragma unroll
      for (int i = 0; i < 8; ++i) g[i] = t.has_gain ? g[i] : 1.f; }
#pragma unroll
    for (int q = 0; q < 4; ++q) { const int n = nl + 8 * q;
        const LAS float* s = (const LAS float*)slot + (8 * k8) * 32 + 4 * ((n >> 2) ^ k8) + (n & 3);
        v4u o; o.x = pg8::cvt_pk_bf16(s[0] * g[0], s[32] * g[1]); o.y = pg8::cvt_pk_bf16(s[64] * g[2], s[96] * g[3]);
        o.z = pg8::cvt_pk_bf16(s[128] * g[4], s[160] * g[5]); o.w = pg8::cvt_pk_bf16(s[192] * g[6], s[224] * g[7]);
        const int nn = t.n0 + 32 * w + n; int row = nn;
        if (t.rowmode == 1) row = 256 * (nn >> 7) + (nn & 127);
        if (t.rowmode == 2) row = 256 * (nn >> 7) + 128 + (nn & 127);
        *(GAS v4u*)(t.WT + (size_t)row * t.K + t.k0 + 8 * k8) = o; }
}

__device__ __forceinline__ void p0_convert_tiles(Frame& F, int first, int stride, int nT) {
    LAS unsigned char* slot0 = F.lds + RING_OFF + F.wave * (2 * P0_SLOT); LAS unsigned char* slot1 = slot0 + P0_SLOT;
    P0Tile ta, tb; const int w = F.wave;
    p0_tile_decode(F, first, ta); p0_strip_issue(ta, w, F.lane, slot0);
    for (int i = 0; i < nT; i += 2) {
        p0_tile_decode(F, first + min(i + 1, nT - 1) * stride, tb); p0_strip_issue(tb, w, F.lane, slot1);
        asm volatile("s_waitcnt vmcnt(9)" ::: "memory");
        p0_strip_finish(ta, w, F.lane, slot0);
        if (i + 1 >= nT) break;
        p0_tile_decode(F, first + min(i + 2, nT - 1) * stride, ta); p0_strip_issue(ta, w, F.lane, slot0);
        asm volatile("s_waitcnt vmcnt(9)" ::: "memory");
        p0_strip_finish(tb, w, F.lane, slot1);
    }
    VM_WAIT(); LDS_WAIT(); __builtin_amdgcn_s_barrier();
}
constexpr int P0_LATE_GRID = 256, P0_LATE_PER_WG = 18, P0_LATE_SLOTS = 3, P0_LATE_PER_SLOT = 128 * P0_LATE_PER_WG, P0_LATE = P0_LATE_SLOTS * P0_LATE_PER_SLOT;
static_assert(P0_TOTAL - P0_LATE >= 1 * P0_PER_LAYER && P0_TOTAL - P0_LATE + 1 * P0_LATE_PER_SLOT >= 2 * P0_PER_LAYER && P0_TOTAL - P0_LATE + 2 * P0_LATE_PER_SLOT >= 3 * P0_PER_LAYER, "slot l converts tiles of layers > l only");
__device__ __forceinline__ void p0_late_slot(Frame& F, int l) {
    if (F.G != P0_LATE_GRID || l >= P0_LATE_SLOTS || F.bid < 128) return;
    p0_convert_tiles(F, P0_TOTAL - P0_LATE + l * P0_LATE_PER_SLOT + (F.bid - 128), 128, P0_LATE_PER_WG);
}

__device__ __forceinline__ void p0_prologue(Frame& F) {
    { const int early = (F.G == P0_LATE_GRID) ? P0_TOTAL - P0_LATE : P0_TOTAL; const int c = F.bid, G = F.G;
      if (c < early) p0_convert_tiles(F, c, G, (early - c + G - 1) / G); }
    LAS float* scr = (LAS float*)(F.lds + RING_OFF + F.wave * 16384);
    const int gw = F.bid * NWAVES + F.wave, NGW = F.G * NWAVES;
    for (int it = gw; it < DEPTH * 4 * 8; it += NGW) { const int lg = it >> 3, sub = it & 7;
        p0_transpose_item(ARG_IN(10) + (size_t)lg * 16384, 128, 128, F.PWT() + (size_t)lg * 16384, 0, nullptr, scr, sub, F.lane); }
    { gcf32 sw = ARG_IN(8); const int gt = F.bid * (NWAVES * 64) + F.tid, NT = F.G * NWAVES * 64;
      for (int i = gt; i < DEPTH * 4 * 128 * 128 / 4; i += NT) { const f32x4 v = *(const GAS f32x4*)(sw + (size_t)i * 4); v2u o; o.x = pk2(v.x, v.y); o.y = pk2(v.z, v.w); *(GAS v2u*)(F.SGW() + (size_t)i * 4) = o; } }
    gcf32 x = ARG_IN(0);
    for (int m = gw; m < M; m += NGW) {
        const GAS f32x4* xr = (const GAS f32x4*)(x + (size_t)m * D) + F.lane; GAS v2u* brow = (GAS v2u*)(F.XB() + (size_t)m * D) + F.lane;
        float s = 0.f;
#pragma unroll
        for (int j = 0; j < 8; ++j) { const f32x4 v = xr[64 * j]; s += (v.x * v.x + v.y * v.y) + (v.z * v.z + v.w * v.w); v2u o; o.x = pk2(v.x, v.y); o.y = pk2(v.z, v.w); brow[64 * j] = o; }
        s = wave_sum(s);
        if (F.lane < 8) F.SSQ()[(size_t)m * 8 + F.lane] = (F.lane == 0) ? s : 0.f;
    }
}

constexpr int VT_IMG = 128 * VT_PITCH;
template <int NU> __device__ __forceinline__ void mix_gating_units(Frame& F, int l, int u0, int ustride) {
    const int h = u0 & 3;
    LAS unsigned char* vT = F.lds + RING_OFF;
    {
        const int pos = F.tid >> 2, cq = F.tid & 3;
        v4u w[NU][4];
#pragma unroll
        for (int e = 0; e < NU; ++e) { gcbf zv = F.Z() + (size_t)(((u0 + e * ustride) >> 2) * 128 + pos) * ZW + 512 + h * 128 + cq * 32;
#pragma unroll
            for (int i = 0; i < 4; ++i) w[e][i] = *(const GAS v4u*)(zv + 8 * i); }
        gcf32 gn = ARG_IN(7) + l * 512 + h * 128 + cq * 32;
        f32x4 gv[8];
#pragma unroll
        for (int c4 = 0; c4 < 8; ++c4) gv[c4] = *(const GAS f32x4*)(gn + 4 * c4);
#pragma unroll
        for (int e = 0; e < NU; ++e) {
            float v[32];
#pragma unroll
            for (int i = 0; i < 4; ++i)
#pragma unroll
                for (int k = 0; k < 4; ++k) { const unsigned ww = w[e][i][k]; const f32x2 gl = pg8::gelu_pk((f32x2){bf_lo(ww), bf_hi(ww)}); v[8 * i + 2 * k] = gl.x; v[8 * i + 2 * k + 1] = gl.y; }
            float ss = 0.f;
#pragma unroll
            for (int c = 0; c < 32; ++c) ss += v[c] * v[c];
            ss += __shfl_xor(ss, 1); ss += __shfl_xor(ss, 2);
            const float rstd = __builtin_amdgcn_rsqf(ss * (1.0f / 128.0f) + pg8::RMS_EPS);
#pragma unroll
            for (int c4 = 0; c4 < 8; ++c4)
#pragma unroll
                for (int k = 0; k < 4; ++k) { const int c = 4 * c4 + k; *(LAS unsigned short*)(vT + e * VT_IMG + (cq * 32 + c) * VT_PITCH + pos * 2) = (unsigned short)f2bf(v[c] * rstd * gv[c4][k]); }
        }
    }
    __syncthreads();
    {
        const int fr = F.lane & 15, fq = F.lane >> 4, p = 16 * F.wave + fr;
        gcbf wsrow = F.SGW() + ((size_t)(l * 4 + h) * 128 + p) * 128 + 8 * fq;
        bf16x8 bfrag[4];
#pragma unroll
        for (int ks = 0; ks < 4; ++ks) bfrag[ks] = *(const GAS bf16x8*)(wsrow + 32 * ks);
        const float bias = ARG_IN(9)[(l * 4 + h) * 128 + p];
        v2u zz[NU][8];
#pragma unroll
        for (int e = 0; e < NU; ++e) { gcbf zu = F.Z() + (size_t)(((u0 + e * ustride) >> 2) * 128 + p) * ZW + h * 128 + 4 * fq;
#pragma unroll
            for (int dt = 0; dt < 8; ++dt) zz[e][dt] = *(const GAS v2u*)(zu + 16 * dt); }
#pragma unroll
        for (int e = 0; e < NU; ++e) {
            f32x4 acc[8];
#pragma unroll
            for (int dt = 0; dt < 8; ++dt) acc[dt] = (f32x4){0.f, 0.f, 0.f, 0.f};
#pragma unroll
            for (int ks = 0; ks < 4; ++ks)
#pragma unroll
                for (int dt = 0; dt < 8; ++dt) { const bf16x8 afrag = *(const LAS bf16x8*)(vT + e * VT_IMG + (16 * dt + fr) * VT_PITCH + 64 * ks + 16 * fq);
                    acc[dt] = __builtin_amdgcn_mfma_f32_16x16x32_bf16(afrag, bfrag[ks], acc[dt], 0, 0, 0); }
            gbf o = F.MIX() + (size_t)(((u0 + e * ustride) >> 2) * 128 + p) * D + h * 128 + 4 * fq;
#pragma unroll
            for (int dt = 0; dt < 8; ++dt) { const v2u z2 = zz[e][dt];
                const f32x2 a0 = pg8::gelu_pk((f32x2){bf_lo(z2.x), bf_hi(z2.x)}), a1 = pg8::gelu_pk((f32x2){bf_lo(z2.y), bf_hi(z2.y)});
                v2u wv; wv.x = pg8::cvt_pk_bf16(a0.x * (acc[dt][0] + bias), a0.y * (acc[dt][1] + bias)); wv.y = pg8::cvt_pk_bf16(a1.x * (acc[dt][2] + bias), a1.y * (acc[dt][3] + bias));
                *(GAS v2u*)(o + 16 * dt) = wv; }
        }
    }
    __syncthreads();
}

constexpr int PL_PITCH = 272, PL_IMG = 32 * PL_PITCH, PL_SLOT = 2 * PL_IMG;
static_assert(NWAVES * PL_SLOT <= LDSCTL_OFF, "pool slots fit below the LDS control words");
template <int g, int NUN> __device__ __forceinline__ void mix_pool_units(Frame& F, int l, int u0, int ustride) {
    constexpr int half = 1 << g;
    int lane = F.lane; asm volatile("" : "+v"(lane));
    const int fr = lane & 15, fq = lane >> 4;
    LAS unsigned char* slot = F.lds + RING_OFF + F.wave * PL_SLOT;
    gcbf pw = F.PWT() + (size_t)(l * 4 + g) * 16384 + 8 * fq;
    {
        v4u rv[NUN][8];
#pragma unroll
        for (int e = 0; e < NUN; ++e) { const int tok0 = ((u0 + e * ustride) >> 2) * 16, b = tok0 >> 13, s0 = tok0 & (SEQ - 1);
            gcbf zrow = F.Z() + (size_t)(b * SEQ) * ZW + 1024 + g * 128 + 8 * (lane & 15);
#pragma unroll
            for (int i = 0; i < 8; ++i) { const int pos = min(max(s0 - half + 4 * i + (lane >> 4), 0), SEQ - 1); rv[e][i] = *(const GAS v4u*)(zrow + (size_t)pos * ZW); } }
        __builtin_amdgcn_sched_barrier(0);
#pragma unroll
        for (int e = 0; e < NUN; ++e)
#pragma unroll
            for (int i = 0; i < 8; ++i) *(LAS v4u*)(slot + e * PL_IMG + (4 * i + (lane >> 4)) * PL_PITCH + (lane & 15) * 16) = rv[e][i];
    }
    bf16x8 afr[2][8];
    { gcbf pk = pw + (size_t)fr * 128; asm volatile("" : "+v"(pk));
#pragma unroll
      for (int dt = 0; dt < 8; ++dt) afr[0][dt] = *(const GAS bf16x8*)(pk + 2048 * dt); }
    f32x4 acc[NUN][8];
#pragma unroll
    for (int e = 0; e < NUN; ++e)
#pragma unroll
        for (int dt = 0; dt < 8; ++dt) acc[e][dt] = (f32x4){0.f, 0.f, 0.f, 0.f};
    LDS_WAIT(); asm volatile("" ::: "memory");
    const LAS unsigned char* rbase = slot + fr * PL_PITCH + fq * 16;
#pragma unroll
    for (int ks = 0; ks < 4; ++ks) {
        if (ks + 1 < 4) { gcbf pk = pw + (size_t)fr * 128 + 32 * (ks + 1); asm volatile("" : "+v"(pk));
#pragma unroll
            for (int dt = 0; dt < 8; ++dt) afr[(ks + 1) & 1][dt] = *(const GAS bf16x8*)(pk + 2048 * dt); }
#pragma unroll
        for (int e = 0; e < NUN; ++e) { const int tok0 = ((u0 + e * ustride) >> 2) * 16, s = (tok0 & (SEQ - 1)) + fr;
            const int lo = max(s - half, 0), hi = min(s + half, SEQ); const float inv_cnt = 1.0f / (float)(hi - lo);
            const LAS unsigned char* rb = rbase + e * PL_IMG + ks * 64;
            v4u wv[2 * half];
#pragma unroll
            for (int j = 0; j < 2 * half; ++j) wv[j] = *(const LAS v4u*)(rb + j * PL_PITCH);
            const v4u pc4 = *(const LAS v4u*)(rb + half * PL_PITCH);
            float sum[8];
#pragma unroll
            for (int k = 0; k < 8; ++k) sum[k] = 0.f;
#pragma unroll
            for (int j = 0; j < 2 * half; ++j) { const int pos = s + j - half; const float f = ((pos >= 0) && (pos < SEQ)) ? 1.0f : 0.0f; const v4u w = wv[j];
#pragma unroll
                for (int k = 0; k < 4; ++k) { sum[2 * k] += f * bf_lo(w[k]); sum[2 * k + 1] += f * bf_hi(w[k]); } }
            v4u dfr;
#pragma unroll
            for (int k = 0; k < 4; ++k) dfr[k] = pg8::cvt_pk_bf16(sum[2 * k] * inv_cnt - bf_lo(pc4[k]), sum[2 * k + 1] * inv_cnt - bf_hi(pc4[k]));
            const bf16x8 bfrag = __builtin_bit_cast(bf16x8, dfr);
#pragma unroll
            for (int dt = 0; dt < 8; ++dt) acc[e][dt] = __builtin_amdgcn_mfma_f32_16x16x32_bf16(afr[ks & 1][dt], bfrag, acc[e][dt], 0, 0, 0);
            __builtin_amdgcn_sched_barrier(0);
        }
    }
    gcf32 sc = ARG_IN(11) + l * 512 + g * 128 + 4 * fq;
    f32x4 sv[8];
#pragma unroll
    for (int dt = 0; dt < 8; ++dt) sv[dt] = *(const GAS f32x4*)(sc + 16 * dt);
#pragma unroll
    for (int e = 0; e < NUN; ++e) { const int tok = ((u0 + e * ustride) >> 2) * 16 + fr; gbf o = F.MIX() + (size_t)tok * D + 512 + g * 128 + 4 * fq;
#pragma unroll
        for (int dt = 0; dt < 8; ++dt) { v2u w; w.x = pg8::cvt_pk_bf16(acc[e][dt][0] * sv[dt].x, acc[e][dt][1] * sv[dt].y); w.y = pg8::cvt_pk_bf16(acc[e][dt][2] * sv[dt].z, acc[e][dt][3] * sv[dt].w);
            *(GAS v2u*)(o + 16 * dt) = w; } }
}
template <int NUN> __device__ __forceinline__ void mix_pool_dispatch(Frame& F, int l, int u0, int ustride) {
    const int g = u0 & 3;
    if (g == 0) mix_pool_units<0, NUN>(F, l, u0, ustride); else if (g == 1) mix_pool_units<1, NUN>(F, l, u0, ustride); else if (g == 2) mix_pool_units<2, NUN>(F, l, u0, ustride); else mix_pool_units<3, NUN>(F, l, u0, ustride);
}

__device__ __forceinline__ int na_fk(int key) { return (key & 3) | (((key >> 3) & 3) << 2); }
__device__ __forceinline__ void na_issue(gcbf zk, gcbf vth, int kr, int wave, int lane, LAS unsigned char* buf) {
#pragma unroll
    for (int e = 0; e < 2; ++e) { const int inst = 2 * wave + e;
        { const int key = 4 * inst + (lane >> 4), c = (lane & 15) ^ na_fk(key);
          __builtin_amdgcn_global_load_lds((const GAS unsigned*)(zk + (size_t)(kr * GRID_W + key) * ZW + 8 * c), (LAS unsigned*)(buf + inst * 1024), 16, 0, 0); }
        { const int d = 8 * inst + (lane >> 3), c = (lane & 7) ^ ((d >> 1) & 7);
          __builtin_amdgcn_global_load_lds((const GAS unsigned*)(vth + (size_t)d * SEQ + kr * GRID_W + 8 * c), (LAS unsigned*)(buf + 16384 + inst * 1024), 16, 0, 0); } }
}
__device__ __forceinline__ void mix_na_unit(Frame& F, int unit) {
    const int b = unit >> 8, h = (unit >> 5) & 7, rq = unit & 31;
    const int fr = F.lane & 15, fq = F.lane >> 4;
    const int r = 4 * rq + (F.wave >> 1), i0 = 2 * (F.wave & 1);
    const int sr = min(max(r - 4, 0), GRID_ROWS - 8);
    const int kr_lo = min(max(4 * rq - 4, 0), GRID_ROWS - 8), kr_hi = min(max(4 * rq - 1, 0), GRID_ROWS - 8) + 7, nsteps = kr_hi - kr_lo + 1;
    const LAS float* rpb = (const LAS float*)(F.lds + RPB_OFF) + h * (15 * 31);
    gcbf zk = F.Z() + (size_t)(b * SEQ) * ZW + 2560 + h * 128;
    gcbf vth = F.VT() + (size_t)(b * 1024 + h * 128) * SEQ;
    LAS unsigned char* nab = F.lds + RING_OFF;
    bf16x8 qf[2][4];
#pragma unroll
    for (int ii = 0; ii < 2; ++ii) { gcbf qp = F.Z() + (size_t)(b * SEQ + r * GRID_W + 16 * (i0 + ii) + fr) * ZW + 1536 + h * 128 + 8 * fq;
#pragma unroll
        for (int ks = 0; ks < 4; ++ks) qf[ii][ks] = *(const GAS bf16x8*)(qp + 32 * ks); }
    f32x4 oacc[2][8]; float mrun[2], lrun[2];
#pragma unroll
    for (int ii = 0; ii < 2; ++ii) { mrun[ii] = -1e30f; lrun[ii] = 0.f;
#pragma unroll
        for (int dt = 0; dt < 8; ++dt) oacc[ii][dt] = (f32x4){0.f, 0.f, 0.f, 0.f}; }
    __syncthreads();
    na_issue(zk, vth, kr_lo, F.wave, F.lane, nab);
    for (int t = 0; t < nsteps; ++t) {
        asm volatile("s_waitcnt vmcnt(0)" ::: "memory"); __builtin_amdgcn_s_barrier(); asm volatile("" ::: "memory");
        if (t + 1 < nsteps) na_issue(zk, vth, kr_lo + t + 1, F.wave, F.lane, nab + ((t + 1) & 1) * 32768);
        const int kr = kr_lo + t;
        if (kr >= sr && kr <= sr + 7) {
            const LAS unsigned char* kb = nab + (t & 1) * 32768; const LAS unsigned char* vb = kb + 16384;
            const LAS float* rrow = rpb + (kr - r + 7) * 31;
#pragma unroll
            for (int ii = 0; ii < 2; ++ii) {
                const int i = i0 + ii, qc = 16 * i + fr;
                const int cb = (i == 0) ? 0 : (i == 1) ? 8 : (i == 2) ? 24 : 32;
                const int cs = min(max(qc - 8, 0), GRID_W - 16);
                bf16x8 kf[2][4]; float bias[8];
#pragma unroll
                for (int hh = 0; hh < 2; ++hh) { const int kcl = cb + 8 * (fr >> 2) + (fr & 3) + 4 * hh, fk = na_fk(kcl);
#pragma unroll
                    for (int ks = 0; ks < 4; ++ks) kf[hh][ks] = *(const LAS bf16x8*)(kb + kcl * 256 + (((4 * ks + fq) ^ fk) << 4)); }
#pragma unroll
                for (int k = 0; k < 8; ++k) { const int kc = cb + 8 * fq + k; bias[k] = rrow[min(max(kc - qc + 15, 0), 30)]; }
                __builtin_amdgcn_sched_barrier(0);
#pragma unroll
                for (int k = 0; k < 8; ++k) asm volatile("" : "+v"(bias[k]));
                f32x4 sa[2];
#pragma unroll
                for (int hh = 0; hh < 2; ++hh) { f32x4 a = (f32x4){0.f, 0.f, 0.f, 0.f};
#pragma unroll
                    for (int ks = 0; ks < 4; ++ks) a = __builtin_amdgcn_mfma_f32_16x16x32_bf16(kf[hh][ks], qf[ii][ks], a, 0, 0, 0);
                    sa[hh] = a; }
                float sv[8]; float mt = -1e30f;
#pragma unroll
                for (int hh = 0; hh < 2; ++hh)
#pragma unroll
                    for (int j = 0; j < 4; ++j) { const int kc = cb + 8 * fq + 4 * hh + j; const bool ok = (kc >= cs) && (kc < cs + 16);
                        const float x = ok ? (sa[hh][j] * NA_SCALE + bias[4 * hh + j]) : -1e30f; sv[4 * hh + j] = x; mt = fmaxf(mt, x); }
                mt = fmaxf(mt, __shfl_xor(mt, 16)); mt = fmaxf(mt, __shfl_xor(mt, 32));
                const float mnew = fmaxf(mrun[ii], mt), alpha = __builtin_amdgcn_exp2f((mrun[ii] - mnew) * 1.44269504089f);
                mrun[ii] = mnew;
                float e[8], ps = 0.f;
#pragma unroll
                for (int k = 0; k < 8; ++k) { e[k] = __builtin_amdgcn_exp2f((sv[k] - mnew) * 1.44269504089f); ps += e[k]; }
                lrun[ii] = lrun[ii] * alpha + ps;
                v4u pw; pw.x = pg8::cvt_pk_bf16(e[0], e[1]); pw.y = pg8::cvt_pk_bf16(e[2], e[3]); pw.z = pg8::cvt_pk_bf16(e[4], e[5]); pw.w = pg8::cvt_pk_bf16(e[6], e[7]);
                const bf16x8 pf = __builtin_bit_cast(bf16x8, pw);
#pragma unroll
                for (int dh = 0; dh < 2; ++dh) { bf16x8 vf[4];
#pragma unroll
                    for (int dq = 0; dq < 4; ++dq) { const int d = 16 * (4 * dh + dq) + fr; vf[dq] = *(const LAS bf16x8*)(vb + d * 128 + ((((cb >> 3) + fq) ^ ((d >> 1) & 7)) << 4)); }
                    __builtin_amdgcn_sched_barrier(0);
#pragma unroll
                    for (int dq = 0; dq < 4; ++dq) oacc[ii][4 * dh + dq] = __builtin_amdgcn_mfma_f32_16x16x32_bf16(vf[dq], pf, oacc[ii][4 * dh + dq] * alpha, 0, 0, 0); }
            }
        }
    }
#pragma unroll
    for (int ii = 0; ii < 2; ++ii) { float l = lrun[ii]; l += __shfl_xor(l, 16); l += __shfl_xor(l, 32); const float inv = 1.0f / l;
        gbf op = F.MIX() + (size_t)(b * SEQ + r * GRID_W + 16 * (i0 + ii) + fr) * D + 1024 + h * 128 + 4 * fq;
#pragma unroll
        for (int dt = 0; dt < 8; ++dt) { const f32x4 o = oacc[ii][dt]; v2u w; w.x = pg8::cvt_pk_bf16(o[0] * inv, o[1] * inv); w.y = pg8::cvt_pk_bf16(o[2] * inv, o[3] * inv); *(GAS v2u*)(op + 16 * dt) = w; } }
}

__device__ __forceinline__ void mix_phase(Frame& F, int l) {
    {
        constexpr int NUNITS = (M / 128) * 4;
        if ((F.G & 3) == 0) { for (int u = F.bid; u < NUNITS; u += 2 * F.G) { if (u + F.G < NUNITS) mix_gating_units<2>(F, l, u, F.G); else mix_gating_units<1>(F, l, u, 0); } }
        else for (int u = F.bid; u < NUNITS; u += F.G) mix_gating_units<1>(F, l, u, 0);
    }
    const int gw = F.bid * NWAVES + F.wave, NGW = F.G * NWAVES;
    {
        constexpr int NUNITS = (M / 16) * 4;
        if ((NGW & 3) == 0) { for (int u = gw; u < NUNITS; u += 2 * NGW) { if (u + NGW < NUNITS) mix_pool_dispatch<2>(F, l, u, NGW); else mix_pool_dispatch<1>(F, l, u, 0); } }
        else for (int u = gw; u < NUNITS; u += NGW) mix_pool_dispatch<1>(F, l, u, 0);
    }
    __syncthreads();
    { gcf32 rp = ARG_IN(12) + (size_t)l * (8 * 15 * 31); LAS float* t = (LAS float*)(F.lds + RPB_OFF);
      for (int i = F.tid; i < 8 * 15 * 31; i += NWAVES * 64) t[i] = rp[i]; }
    for (int u = F.bid; u < BATCH * 8 * (GRID_ROWS / 4); u += F.G) mix_na_unit(F, u);
    __syncthreads();
}

#define PHASE_FRAME(F) Frame F; { unsigned z_ = 0u; asm volatile("" : "+s"(z_)); int t_ = (int)__builtin_amdgcn_mbcnt_hi(~0u, __builtin_amdgcn_mbcnt_lo(~0u, z_)) + 64 * wave_id_; asm volatile("" : "+v"(t_)); kargp a_ = (kargp)__builtin_amdgcn_kernarg_segment_ptr(); asm volatile("" : "+s"(a_)); \
    F.lds = (LAS unsigned char*)lds; F.tid = t_; F.lane = t_ & 63; F.wave = __builtin_amdgcn_readfirstlane(t_ >> 6); { int g_ = (int)gridDim.x, c_ = (int)blockIdx.x; asm volatile("" : "+s"(g_), "+s"(c_)); F.G = g_; F.bid = c_; } F.ap = a_; F.X = (GAS float*)a_->out; F.ws = (gptr)a_->ws; }
__global__ void __launch_bounds__(NWAVES * 64, 2) mega_fwd(Args args) {
    extern __shared__ __attribute__((aligned(16))) unsigned char lds[];
    const int wave_id_ = __builtin_amdgcn_readfirstlane((int)threadIdx.x >> 6);
    for (int u = threadIdx.x; u < (LDS_BYTES - LDSCTL_OFF) / 4; u += NWAVES * 64) ((LAS unsigned*)((LAS unsigned char*)lds + LDSCTL_OFF))[u] = 0u;
    __syncthreads();
    (void)xcd_barrier_post((xbp)(args.ws + WS_CTL) + CW_BAR, (volatile LAS unsigned*)((LAS unsigned char*)lds + MISC_OFF) + 8);
#define GRID_BAR() do { kargp a_ = (kargp)__builtin_amdgcn_kernarg_segment_ptr(); asm volatile("" : "+s"(a_)); XcdBarrier b_; b_.bar = (xbp)((gptr)a_->ws + WS_CTL) + CW_BAR; b_.x = xb_xcc_id(); \
        b_.st = (volatile LAS unsigned*)((LAS unsigned char*)lds + MISC_OFF) + 8; unsigned z_ = 0u; asm volatile("" : "+s"(z_)); b_.t0 = (wave_id_ == 0) && (__builtin_amdgcn_mbcnt_hi(~0u, __builtin_amdgcn_mbcnt_lo(~0u, z_)) == 0u); xcd_barrier(b_); } while (0)

    { PHASE_FRAME(F); p0_prologue(F); }
    GRID_BAR();

    for (int s = 0; s < 2 * DEPTH; ++s) {
        const int l = s >> 1, j = s & 1;
        {
            PHASE_FRAME(F); gptr wl = F.ws + WS_W + (size_t)l * LW_BYTES;
            pg8::Gemm g{F.XB(), (gcbf)(wl + (j ? LW_GU2 : LW_GU1)), M, NGU, D}; pg8::StaticOrder S; S.init(M, NGU, F.G, F.bid, 8);
            pg8::EpiGateUp E{F.ACT(), FF, pg8::RowRstdLds{F.SSQ(), (LAS float*)(F.lds + SCR_OFF)}};
            pg8::gemm_phase<pg8::EpiGateUp, pg8::StaticOrder, true, true>(F.lds + RING_OFF, g, S, E, F.tid);
        }
        GRID_BAR();
        {
            PHASE_FRAME(F); gptr wl = F.ws + WS_W + (size_t)l * LW_BYTES;
            pg8::Gemm g{F.ACT(), (gcbf)(wl + (j ? LW_D2 : LW_D1)), M, D, FF}; pg8::StaticOrder S; S.init(M, D, F.G, F.bid);
            pg8::EpiResid E{(GAS float*)nullptr, F.XB(), F.SSQ(), 0.5f, (LAS float*)(F.lds + SCR_OFF), F.tid};
            pg8::gemm_phase<pg8::EpiResid, pg8::StaticOrder, true, true, true>(F.lds + RING_OFF, g, S, E, F.tid);
        }
        GRID_BAR();
        if (j == 0) {
            {
                PHASE_FRAME(F); gptr wl = F.ws + WS_W + (size_t)l * LW_BYTES;
                pg8::Gemm g{F.XB(), (gcbf)(wl + LW_IN), M, ZW, D}; pg8::StaticOrder S; S.init(M, ZW, F.G, F.bid);
                pg8::EpiZ E{F.Z(), ZW, pg8::RowRstdLds{F.SSQ(), (LAS float*)(F.lds + SCR_OFF)}};
                pg8::gemm_phase<pg8::EpiZ, pg8::StaticOrder, true, true>(F.lds + RING_OFF, g, S, E, F.tid);
            }
            {
                PHASE_FRAME(F); gptr wl = F.ws + WS_W + (size_t)l * LW_BYTES;
                pg8::Gemm g{(gcbf)(wl + LW_IN) + (size_t)ZW * D, F.XB(), NVT, M, D}; pg8::StaticOrder S; S.init(NVT, M, F.G, F.bid);
                pg8::EpiVT E{F.VT(), F.SSQ()};
                pg8::gemm_phase<pg8::EpiVT, pg8::StaticOrder, true, true>(F.lds + RING_OFF, g, S, E, F.tid);
            }
            { PHASE_FRAME(F); p0_late_slot(F, l); }
            GRID_BAR();
            { PHASE_FRAME(F); mix_phase(F, l); }
            GRID_BAR();
            {
                PHASE_FRAME(F); gptr wl = F.ws + WS_W + (size_t)l * LW_BYTES;
                pg8::Gemm g{F.MIX(), (gcbf)(wl + LW_OUT), M, D, D}; pg8::StaticOrder S; S.init(M, D, F.G, F.bid);
                pg8::EpiResid E{(GAS float*)nullptr, F.XB(), F.SSQ(), 1.0f, (LAS float*)(F.lds + SCR_OFF), F.tid};
                pg8::gemm_phase<pg8::EpiResid, pg8::StaticOrder, true, true>(F.lds + RING_OFF, g, S, E, F.tid);
            }
            GRID_BAR();
        }
    }
    {
        PHASE_FRAME(F);
        const int gw = F.bid * NWAVES + F.wave, NGW = F.G * NWAVES;
        const GAS f32x4* gp = (const GAS f32x4*)ARG_IN(18) + 2 * F.lane;
        f32x4 gv[4][2];
#pragma unroll
        for (int jj = 0; jj < 4; ++jj) { gv[jj][0] = gp[128 * jj]; gv[jj][1] = gp[128 * jj + 1]; }
        for (int m = gw; m < M; m += NGW) { const float rs = pg8::row_rstd(F.SSQ(), m);
            const GAS pg8::u32x4* xr = (const GAS pg8::u32x4*)(F.XB() + (size_t)m * D) + F.lane; GAS f32x4* orow = (GAS f32x4*)(F.X + (size_t)m * D) + 2 * F.lane;
            pg8::u32x4 xv[4];
#pragma unroll
            for (int jj = 0; jj < 4; ++jj) xv[jj] = xr[64 * jj];
#pragma unroll
            for (int jj = 0; jj < 4; ++jj) { const pg8::u32x4 x = xv[jj]; f32x4 y0, y1;
                y0[0] = __builtin_bit_cast(float, x.x << 16); y0[1] = __builtin_bit_cast(float, x.x & 0xffff0000u); y0[2] = __builtin_bit_cast(float, x.y << 16); y0[3] = __builtin_bit_cast(float, x.y & 0xffff0000u);
                y1[0] = __builtin_bit_cast(float, x.z << 16); y1[1] = __builtin_bit_cast(float, x.z & 0xffff0000u); y1[2] = __builtin_bit_cast(float, x.w << 16); y1[3] = __builtin_bit_cast(float, x.w & 0xffff0000u);
                orow[128 * jj] = y0 * rs * gv[jj][0]; orow[128 * jj + 1] = y1 * rs * gv[jj][1]; } }
    }
}

extern "C" void kernel_launch(void* const* d_in, const int* in_sizes, int n_in, void* d_out, int out_size, void* d_ws, size_t ws_size, hipStream_t stream) {
    static int grid = 0;
    if (grid == 0) {
        if (n_in != 19 || in_sizes[0] != M * D || out_size != M * D || ws_size < WS_END) { fprintf(stderr, "kernel_launch: unexpected shapes: n_in %d in0 %d out %d ws %zu (need %zu)\n", n_in, n_in > 0 ? in_sizes[0] : -1, out_size, ws_size, (size_t)WS_END); grid = -1; return; }
        int dev = 0, cus = 0, per_cu = 0;
        if (hipGetDevice(&dev) != hipSuccess || hipDeviceGetAttribute(&cus, hipDeviceAttributeMultiprocessorCount, dev) != hipSuccess) { fprintf(stderr, "kernel_launch: device query failed\n"); grid = -1; return; }
        if (hipFuncSetAttribute((const void*)mega_fwd, hipFuncAttributeMaxDynamicSharedMemorySize, LDS_BYTES) != hipSuccess) { fprintf(stderr, "kernel_launch: hipFuncSetAttribute failed\n"); grid = -1; return; }
        if (hipOccupancyMaxActiveBlocksPerMultiprocessor(&per_cu, (const void*)mega_fwd, NWAVES * 64, LDS_BYTES) != hipSuccess || per_cu < 1)
            fprintf(stderr, "kernel_launch: note: occupancy query reports %d workgroups per CU\n", per_cu);
        (void)hipGetLastError();
        grid = cus;
    }
    if (grid < 0) return;
    if (hipMemsetAsync((char*)d_ws + WS_CTL, 0, CTL_ZERO_BYTES, stream) != hipSuccess) { fprintf(stderr, "kernel_launch: memset failed\n"); return; }
    Args a{};
    for (int i = 0; i < 19; ++i) a.in[i] = (const float*)d_in[i];
    a.out = (float*)d_out; a.ws = (unsigned char*)d_ws;
    hipLaunchKernelGGL(mega_fwd, dim3(grid), dim3(NWAVES * 64), LDS_BYTES, stream, a);
    const hipError_t le = hipPeekAtLastError();
    if (le != hipSuccess) fprintf(stderr, "kernel_launch: launch failed: %s\n", hipGetErrorName(le));
}
```

```cpp
#include <hip/hip_runtime.h>
#include <cstdio>
#include <cstdint>

namespace pg8 {
#define PG8_LAS __attribute__((address_space(3)))
#define PG8_GAS __attribute__((address_space(1)))
typedef unsigned short bf16_t;
typedef short bf16x8 __attribute__((ext_vector_type(8)));
typedef float f32x4 __attribute__((ext_vector_type(4)));
typedef float f32x2 __attribute__((ext_vector_type(2)));
typedef unsigned u32x4 __attribute__((ext_vector_type(4)));
typedef unsigned u32x2 __attribute__((ext_vector_type(2)));
constexpr int BM = 256, BK = 64, HALF = 128, HTB = HALF * BK * 2  , STAGE_BYTES = 8 * HTB, NXCD = 8, WGM = 4;

__host__ __device__ __forceinline__ int lds_byte(int r, int c) { const int st = (r >> 4) * 2 + (c >> 5), rr = r & 15, cc = c & 31, ob = rr * 64 + cc * 2; return st * 1024 + (ob ^ (((ob >> 9) & 1) << 5)); }
__host__ __device__ __forceinline__ void stage_rc(int b, int& R, int& C) { const int st = b / 1024, sb = b % 1024, swz = sb ^ (((sb >> 9) & 1) << 5); R = (st >> 1) * 16 + swz / 64; C = (st & 1) * 32 + (swz % 64) / 2; }
__host__ __device__ __forceinline__ int perm32(int rho) { const int n = rho >> 4, i = rho & 15; return 8 * (i >> 2) + 4 * n + (i & 3); }

struct Unit { int pm, pn; };
struct Gemm { const PG8_GAS bf16_t* A; const PG8_GAS bf16_t* Bt; int M, N, K; };

struct StaticOrder {
    int nM, nN, nwg, G, c, wgm;
    __host__ __device__ void init(int M, int N, int G_, int c_, int wgm_ = WGM) { nM = M / BM; nN = N / BM; nwg = nM * nN; G = G_; c = c_; wgm = wgm_; }
    __host__ __device__ bool next(int i, Unit& u) const {
        const long L = (long)i * G + c; if (L >= nwg) return false;
        int wgid = (int)L; { const int q = nwg / NXCD, r = nwg % NXCD, xcd = wgid % NXCD, off = wgid / NXCD; wgid = (xcd < r ? xcd * (q + 1) : r * (q + 1) + (xcd - r) * q) + off; }
        const int nig = wgm * nN, gid = wgid / nig, fm = gid * wgm, gsz = (nM - fm) < wgm ? (nM - fm) : wgm;
        u.pm = fm + ((wgid % nig) % gsz); u.pn = (wgid % nig) / gsz; return true;
    }
    __device__ __forceinline__ void a_ready(const Unit&) const {}
    __device__ __forceinline__ void done(const Unit&) const {}
};

__device__ __forceinline__ unsigned cvt_pk_bf16(float lo, float hi) { unsigned r; asm volatile("v_cvt_pk_bf16_f32 %0, %1, %2" : "=v"(r) : "v"(lo), "v"(hi)); return r; }
__device__ __forceinline__ f32x2 gelu_pk(f32x2 v) {
    const f32x2 av = __builtin_elementwise_abs(v), d = av * 0.2316418882f + 1.0f;
    f32x2 t; t.x = __builtin_amdgcn_rcpf(d.x); t.y = __builtin_amdgcn_rcpf(d.y);
    f32x2 q = t * 0.5307027145f + (-0.7265760135f); q = q * t + 0.7107068705f; q = q * t + (-0.142248368f); q = q * t + 0.127414796f; q = q * t;
    const f32x2 s = (v * v) * (-0.72134752044f);
    f32x2 e; e.x = __builtin_amdgcn_exp2f(s.x); e.y = __builtin_amdgcn_exp2f(s.y);
    const f32x2 m = v * (q * e), r = v - m;
    f32x2 o; o.x = v.x < 0.f ? m.x : r.x; o.y = v.y < 0.f ? m.y : r.y; return o;
}
__device__ __forceinline__ float silu_mul(float g, float u) {
    const float e = __builtin_amdgcn_exp2f(g * -1.44269504089f);
    return g * __builtin_amdgcn_rcpf(1.0f + e) * u;
}
constexpr float RMS_EPS = 1e-6f;
__device__ __forceinline__ float row_rstd(const PG8_GAS float* ssq, int row) {
    const f32x4 a = *(const PG8_GAS f32x4*)(ssq + (size_t)row * 8), b = *(const PG8_GAS f32x4*)(ssq + (size_t)row * 8 + 4);
    const float s = ((a.x + a.y) + (a.z + a.w)) + ((b.x + b.y) + (b.z + b.w));
    return __builtin_amdgcn_rsqf(s * (1.0f / 2048.0f) + RMS_EPS);
}

__device__ __forceinline__ void rows_rstd8(const PG8_GAS float* ssq, int row0, float (&rsv)[2][4]) {
    f32x4 pa[2][4], pb[2][4];
#pragma unroll
    for (int ai = 0; ai < 2; ++ai)
#pragma unroll
        for (int m = 0; m < 4; ++m) { const PG8_GAS f32x4* p = (const PG8_GAS f32x4*)(ssq + (size_t)(row0 + ai * HALF + m * 16) * 8); pa[ai][m] = p[0]; pb[ai][m] = p[1]; }
    __builtin_amdgcn_sched_barrier(0);
#pragma unroll
    for (int ai = 0; ai < 2; ++ai)
#pragma unroll
        for (int m = 0; m < 4; ++m) { const f32x4 a = pa[ai][m], b = pb[ai][m]; const float s = ((a.x + a.y) + (a.z + a.w)) + ((b.x + b.y) + (b.z + b.w));
            rsv[ai][m] = __builtin_amdgcn_rsqf(s * (1.0f / 2048.0f) + RMS_EPS); }
}
constexpr int RRL_MAX = 11;
struct RowRstdLds {
    const PG8_GAS float* ssq; PG8_LAS float* tab;
    template <class Sched> __device__ __forceinline__ void prep_all(const Sched& S, int tid) const {
        if (tid < 256) { f32x4 pa[RRL_MAX], pb[RRL_MAX];
#pragma unroll
            for (int i = 0; i < RRL_MAX; ++i) { Unit u; const bool ok = S.next(i, u); const int row = (ok ? u.pm : 0) * BM + tid; const PG8_GAS f32x4* p = (const PG8_GAS f32x4*)(ssq + (size_t)row * 8); pa[i] = p[0]; pb[i] = p[1]; }
            __builtin_amdgcn_sched_barrier(0);
#pragma unroll
            for (int i = 0; i < RRL_MAX; ++i) { const f32x4 a = pa[i], b = pb[i]; const float s = ((a.x + a.y) + (a.z + a.w)) + ((b.x + b.y) + (b.z + b.w)); tab[i * 256 + tid] = __builtin_amdgcn_rsqf(s * (1.0f / 2048.0f) + RMS_EPS); } }
    }
};

struct EpiGateUp {
    static constexpr bool PERM = true, AFTER_DRAIN = false, ROW_RSTD_LDS = true;
    PG8_GAS bf16_t* O; int ldo; RowRstdLds R;
    __device__ __forceinline__ void operator()(const f32x4 (&acc)[2][2][4][2], const Unit& u, int wr, int wc, int fr, int fq, int ui) const {
        const int row0 = u.pm * BM + wr * 64 + fr, col0 = u.pn * HALF + wc * 32 + 8 * fq;
        float rsv[2][4];
        if (ui < RRL_MAX) { const PG8_LAS float* rt = R.tab + ui * 256 + wr * 64 + fr;
#pragma unroll
            for (int ai = 0; ai < 2; ++ai)
#pragma unroll
                for (int m = 0; m < 4; ++m) rsv[ai][m] = rt[ai * HALF + m * 16]; }
        else rows_rstd8(R.ssq, row0, rsv);
#pragma unroll
        for (int ai = 0; ai < 2; ++ai)
#pragma unroll
            for (int m = 0; m < 4; ++m) { const int row = row0 + ai * HALF + m * 16; const float rs = rsv[ai][m], c2 = __builtin_amdgcn_rcpf(rs * rs), cg = rs * -1.44269504089f;
                u32x4 w;
#pragma unroll
                for (int n = 0; n < 2; ++n) { const f32x4 g = acc[ai][0][m][n], u = acc[ai][1][m][n]; const f32x4 a = g * cg; f32x4 e;
                    e[0] = __builtin_amdgcn_exp2f(a[0]); e[1] = __builtin_amdgcn_exp2f(a[1]); e[2] = __builtin_amdgcn_exp2f(a[2]); e[3] = __builtin_amdgcn_exp2f(a[3]);
                    const f32x4 d = e * c2 + c2; f32x4 r;
                    r[0] = __builtin_amdgcn_rcpf(d[0]); r[1] = __builtin_amdgcn_rcpf(d[1]); r[2] = __builtin_amdgcn_rcpf(d[2]); r[3] = __builtin_amdgcn_rcpf(d[3]);
                    const f32x4 o = (g * u) * r;
                    if (n == 0) { w.x = cvt_pk_bf16(o[0], o[1]); w.y = cvt_pk_bf16(o[2], o[3]); } else { w.z = cvt_pk_bf16(o[0], o[1]); w.w = cvt_pk_bf16(o[2], o[3]); } }
                *(PG8_GAS u32x4*)(O + (size_t)row * ldo + col0) = w; }
    }
};
struct EpiZ {
    static constexpr bool PERM = true, AFTER_DRAIN = false, ROW_RSTD_LDS = true;
    PG8_GAS bf16_t* O; int ldo; RowRstdLds R;
    __device__ __forceinline__ void operator()(const f32x4 (&acc)[2][2][4][2], const Unit& u, int wr, int wc, int fr, int fq, int ui) const {
        const int row0 = u.pm * BM + wr * 64 + fr, col0 = u.pn * BM + wc * 32 + 8 * fq;
        float rsv[2][4];
        if (ui < RRL_MAX) { const PG8_LAS float* rt = R.tab + ui * 256 + wr * 64 + fr;
#pragma unroll
            for (int ai = 0; ai < 2; ++ai)
#pragma unroll
                for (int m = 0; m < 4; ++m) rsv[ai][m] = rt[ai * HALF + m * 16]; }
        else rows_rstd8(R.ssq, row0, rsv);
#pragma unroll
        for (int ai = 0; ai < 2; ++ai)
#pragma unroll
            for (int m = 0; m < 4; ++m) { const int row = row0 + ai * HALF + m * 16; const float rs = rsv[ai][m]; PG8_GAS bf16_t* rowp = O + (size_t)row * ldo + col0;
#pragma unroll
                for (int bj = 0; bj < 2; ++bj) { const f32x4 v0 = acc[ai][bj][m][0] * rs, v1 = acc[ai][bj][m][1] * rs;
                    u32x4 w; w.x = cvt_pk_bf16(v0[0], v0[1]); w.y = cvt_pk_bf16(v0[2], v0[3]); w.z = cvt_pk_bf16(v1[0], v1[1]); w.w = cvt_pk_bf16(v1[2], v1[3]);
                    *(PG8_GAS u32x4*)(rowp + bj * HALF) = w; } }
    }
};
struct EpiVT {
    static constexpr bool PERM = true, AFTER_DRAIN = false, ROW_RSTD_LDS = false;
    PG8_GAS bf16_t* O; const PG8_GAS float* ssq;
    __device__ __forceinline__ void operator()(const f32x4 (&acc)[2][2][4][2], const Unit& u, int wr, int wc, int fr, int fq) const {
        const int row0 = u.pm * BM + wr * 64 + fr, tok0 = u.pn * BM + wc * 32 + 8 * fq;
        const int b = tok0 >> 13, s0 = tok0 & 8191;
#pragma unroll
        for (int bj = 0; bj < 2; ++bj) { float rs[8];
            { f32x4 pa[8], pb[8];
#pragma unroll
              for (int j = 0; j < 8; ++j) { const PG8_GAS f32x4* p = (const PG8_GAS f32x4*)(ssq + (size_t)(tok0 + bj * HALF + j) * 8); pa[j] = p[0]; pb[j] = p[1]; }
              __builtin_amdgcn_sched_barrier(0);
#pragma unroll
              for (int j = 0; j < 8; ++j) { const f32x4 a = pa[j], b = pb[j]; const float s = ((a.x + a.y) + (a.z + a.w)) + ((b.x + b.y) + (b.z + b.w)); rs[j] = __builtin_amdgcn_rsqf(s * (1.0f / 2048.0f) + RMS_EPS); } }
#pragma unroll
            for (int ai = 0; ai < 2; ++ai)
#pragma unroll
                for (int m = 0; m < 4; ++m) { const int n = row0 + ai * HALF + m * 16; const f32x4 v0 = acc[ai][bj][m][0], v1 = acc[ai][bj][m][1];
                    u32x4 w; w.x = cvt_pk_bf16(v0[0] * rs[0], v0[1] * rs[1]); w.y = cvt_pk_bf16(v0[2] * rs[2], v0[3] * rs[3]); w.z = cvt_pk_bf16(v1[0] * rs[4], v1[1] * rs[5]); w.w = cvt_pk_bf16(v1[2] * rs[6], v1[3] * rs[7]);
                    *(PG8_GAS u32x4*)(O + ((size_t)(b * 1024 + n) * 8192 + s0 + bj * HALF)) = w; } }
    }
};
struct EpiResid {
    static constexpr bool PERM = true, AFTER_DRAIN = false, ROW_RSTD_LDS = false;
    PG8_GAS float* Xf; PG8_GAS bf16_t* XB; PG8_GAS float* ssq; float scale; PG8_LAS float* scr; int tid;
    __device__ __forceinline__ void operator()(const f32x4 (&acc)[2][2][4][2], const Unit& u, int wr, int wc, int fr, int fq) const {
        const int row0 = u.pm * BM + wr * 64 + fr, col0 = u.pn * BM + wc * 32 + 8 * fq;
        PG8_GAS bf16_t* bp0 = XB + (size_t)row0 * 2048 + col0;
        u32x4 xo[2][4][2];
#pragma unroll
        for (int ai = 0; ai < 2; ++ai)
#pragma unroll
            for (int m = 0; m < 4; ++m)
#pragma unroll
                for (int bj = 0; bj < 2; ++bj) xo[ai][m][bj] = *(const PG8_GAS u32x4*)(bp0 + (size_t)(ai * HALF + m * 16) * 2048 + bj * HALF);
        float ssv[2][4];
#pragma unroll
        for (int ai = 0; ai < 2; ++ai)
#pragma unroll
            for (int m = 0; m < 4; ++m) { float ss = 0.f;
#pragma unroll
                for (int bj = 0; bj < 2; ++bj) { const u32x4 x = xo[ai][m][bj];
                    f32x4 y0, y1;
                    y0[0] = __builtin_bit_cast(float, x.x << 16) + acc[ai][bj][m][0][0] * scale; y0[1] = __builtin_bit_cast(float, x.x & 0xffff0000u) + acc[ai][bj][m][0][1] * scale;
                    y0[2] = __builtin_bit_cast(float, x.y << 16) + acc[ai][bj][m][0][2] * scale; y0[3] = __builtin_bit_cast(float, x.y & 0xffff0000u) + acc[ai][bj][m][0][3] * scale;
                    y1[0] = __builtin_bit_cast(float, x.z << 16) + acc[ai][bj][m][1][0] * scale; y1[1] = __builtin_bit_cast(float, x.z & 0xffff0000u) + acc[ai][bj][m][1][1] * scale;
                    y1[2] = __builtin_bit_cast(float, x.w << 16) + acc[ai][bj][m][1][2] * scale; y1[3] = __builtin_bit_cast(float, x.w & 0xffff0000u) + acc[ai][bj][m][1][3] * scale;
                    u32x4 w; w.x = cvt_pk_bf16(y0[0], y0[1]); w.y = cvt_pk_bf16(y0[2], y0[3]); w.z = cvt_pk_bf16(y1[0], y1[1]); w.w = cvt_pk_bf16(y1[2], y1[3]);
                    *(PG8_GAS u32x4*)(bp0 + (size_t)(ai * HALF + m * 16) * 2048 + bj * HALF) = w;
                    ss += ((y0[0] * y0[0] + y0[1] * y0[1]) + (y0[2] * y0[2] + y0[3] * y0[3])) + ((y1[0] * y1[0] + y1[1] * y1[1]) + (y1[2] * y1[2] + y1[3] * y1[3])); }
                ssv[ai][m] = ss; }
        { float t[2][4];
#pragma unroll
          for (int ai = 0; ai < 2; ++ai)
#pragma unroll
              for (int m = 0; m < 4; ++m) t[ai][m] = __shfl_xor(ssv[ai][m], 16);
#pragma unroll
          for (int ai = 0; ai < 2; ++ai)
#pragma unroll
              for (int m = 0; m < 4; ++m) ssv[ai][m] += t[ai][m];
#pragma unroll
          for (int ai = 0; ai < 2; ++ai)
#pragma unroll
              for (int m = 0; m < 4; ++m) t[ai][m] = __shfl_xor(ssv[ai][m], 32);
#pragma unroll
          for (int ai = 0; ai < 2; ++ai)
#pragma unroll
              for (int m = 0; m < 4; ++m) { if (fq == 0) scr[(ai * HALF + wr * 64 + m * 16 + fr) * 4 + wc] = ssv[ai][m] + t[ai][m]; } }
        if (Xf) {
            PG8_GAS float* xp0 = Xf + (size_t)row0 * 2048 + col0;
#pragma unroll
            for (int ai = 0; ai < 2; ++ai)
#pragma unroll
                for (int m = 0; m < 4; ++m)
#pragma unroll
                    for (int bj = 0; bj < 2; ++bj) { const u32x4 x = xo[ai][m][bj];
                        f32x4 y0, y1;
                        y0[0] = __builtin_bit_cast(float, x.x << 16) + acc[ai][bj][m][0][0] * scale; y0[1] = __builtin_bit_cast(float, x.x & 0xffff0000u) + acc[ai][bj][m][0][1] * scale;
                        y0[2] = __builtin_bit_cast(float, x.y << 16) + acc[ai][bj][m][0][2] * scale; y0[3] = __builtin_bit_cast(float, x.y & 0xffff0000u) + acc[ai][bj][m][0][3] * scale;
                        y1[0] = __builtin_bit_cast(float, x.z << 16) + acc[ai][bj][m][1][0] * scale; y1[1] = __builtin_bit_cast(float, x.z & 0xffff0000u) + acc[ai][bj][m][1][1] * scale;
                        y1[2] = __builtin_bit_cast(float, x.w << 16) + acc[ai][bj][m][1][2] * scale; y1[3] = __builtin_bit_cast(float, x.w & 0xffff0000u) + acc[ai][bj][m][1][3] * scale;
                        PG8_GAS float* xp = xp0 + (size_t)(ai * HALF + m * 16) * 2048 + bj * HALF; *(PG8_GAS f32x4*)xp = y0; *(PG8_GAS f32x4*)(xp + 4) = y1; }
        }
        asm volatile("s_waitcnt lgkmcnt(0)" ::: "memory"); __builtin_amdgcn_s_barrier(); asm volatile("" ::: "memory");
        if (tid < 256) { const f32x4 p = *(const PG8_LAS f32x4*)(scr + tid * 4); ssq[(size_t)(u.pm * BM + tid) * 8 + u.pn] = (p.x + p.y) + (p.z + p.w); }
    }
};

template <class Epi, class Sched, bool ALIGN_EPI = false, bool SP2 = false, bool KREV = false>
__device__ __forceinline__ void gemm_phase(PG8_LAS unsigned char* lds, const Gemm g, const Sched& S, const Epi& E, int tid_in) {
    int tid_ = tid_in; asm volatile("" : "+v"(tid_));
    const int tid = tid_, wid = __builtin_amdgcn_readfirstlane(tid >> 6), lane = tid & 63, wr = wid >> 2, wc = wid & 3, fr = lane & 15, fq = lane >> 4;
    const int K = g.K, nt = K / BK;
    unsigned voffA[2], voffB[2];
#pragma unroll
    for (int i = 0; i < 2; ++i) { int R, C; stage_rc(tid * 16 + i * 8192, R, C); const int Rb = Epi::PERM ? ((R & ~31) + perm32(R & 31)) : R;
        voffA[i] = (unsigned)(R * K + C) * 2u; voffB[i] = (unsigned)(Rb * K + C) * 2u; }
    const ptrdiff_t kstep = KREV ? -(ptrdiff_t)(BK * 2) : (ptrdiff_t)(BK * 2);
    const size_t hstep = (size_t)HALF * K * 2;
    const size_t tstep = 2 * hstep;
    const unsigned ldsw = (unsigned)wid * 1024u;
    const int aoff = lds_byte(wr * 64 + fr, fq * 8), boff = lds_byte(wc * 32 + fr, fq * 8);
#define PG8_SA(b, h) (((b) * 2 + (h)) * HTB)
#define PG8_SB(b, h) ((4 + (b) * 2 + (h)) * HTB)
#define PG8_STAGE(bufoff, gbase, voff) do { _Pragma("unroll") for (int _i = 0; _i < 2; ++_i) \
        __builtin_amdgcn_global_load_lds((const PG8_GAS unsigned*)((const PG8_GAS char*)(gbase) + (voff)[_i]), (PG8_LAS unsigned*)(lds + (bufoff) + ldsw + _i * 8192), 16, 0, 0); } while (0)
#define PG8_LDA(dst, b, h) do { _Pragma("unroll") for (int m = 0; m < 4; ++m) _Pragma("unroll") for (int k = 0; k < 2; ++k) dst[m][k] = *(const PG8_LAS bf16x8*)(lds + PG8_SA(b, h) + aoff + m * 2048 + k * 1024); } while (0)
#define PG8_LDB(dst, b, h) do { _Pragma("unroll") for (int n = 0; n < 2; ++n) _Pragma("unroll") for (int k = 0; k < 2; ++k) dst[n][k] = *(const PG8_LAS bf16x8*)(lds + PG8_SB(b, h) + boff + n * 2048 + k * 1024); } while (0)
#define PG8_MMA(ai, bj, At, Bt) do { __builtin_amdgcn_s_setprio(1); _Pragma("unroll") for (int m = 0; m < 4; ++m) _Pragma("unroll") for (int n = 0; n < 2; ++n) _Pragma("unroll") for (int k = 0; k < 2; ++k) \
        acc[ai][bj][m][n] = __builtin_amdgcn_mfma_f32_16x16x32_bf16(Bt[n][k], At[m][k], acc[ai][bj][m][n], 0, 0, 0); __builtin_amdgcn_s_setprio(0); } while (0)
#define PG8_WAIT_V(n) asm volatile("s_waitcnt vmcnt(" #n ")" ::: "memory")
#define PG8_WAIT_L(n) asm volatile("s_waitcnt lgkmcnt(" #n ")" ::: "memory")
#define PG8_BAR __builtin_amdgcn_s_barrier()
#define PG8_SCHED __builtin_amdgcn_sched_barrier(0)
    Unit cur, nxt; int ui = 0;
    if (!S.next(0, cur)) return;
    f32x4 acc[2][2][4][2];
#pragma unroll
    for (int a = 0; a < 2; ++a)
#pragma unroll
        for (int b = 0; b < 2; ++b)
#pragma unroll
            for (int m = 0; m < 4; ++m)
#pragma unroll
                for (int n = 0; n < 2; ++n) acc[a][b][m][n] = (f32x4){0.f, 0.f, 0.f, 0.f};
    bf16x8 At[4][2], B0[2][2], B1[2][2];
    const size_t k0off = KREV ? (size_t)(nt - 1) * (size_t)(BK * 2) : (size_t)0;
    const PG8_GAS char* cA = (const PG8_GAS char*)g.A + (size_t)cur.pm * tstep + k0off; const PG8_GAS char* cB = (const PG8_GAS char*)g.Bt + (size_t)cur.pn * tstep + k0off;
    S.a_ready(cur);
    if constexpr (Epi::ROW_RSTD_LDS) E.R.prep_all(S, tid);
    if constexpr (SP2) {
        PG8_STAGE(PG8_SB(0, 0), cB, voffB); PG8_STAGE(PG8_SB(0, 1), cB + hstep, voffB); PG8_STAGE(PG8_SA(0, 0), cA, voffA); PG8_STAGE(PG8_SA(0, 1), cA + hstep, voffA);
        if (wr == 1) PG8_BAR;
        PG8_WAIT_V(2); PG8_BAR;
        PG8_STAGE(PG8_SB(1, 0), cB + kstep, voffB); PG8_STAGE(PG8_SA(1, 0), cA + kstep, voffA); PG8_STAGE(PG8_SB(1, 1), cB + hstep + kstep, voffB);
        PG8_WAIT_V(6); PG8_BAR;
    } else {
        PG8_STAGE(PG8_SB(0, 0), cB, voffB); PG8_STAGE(PG8_SA(0, 0), cA, voffA); PG8_STAGE(PG8_SB(0, 1), cB + hstep, voffB); PG8_STAGE(PG8_SA(0, 1), cA + hstep, voffA);
        if (wr == 1) PG8_BAR;
        PG8_WAIT_V(4); PG8_BAR;
        PG8_STAGE(PG8_SB(1, 0), cB + kstep, voffB); PG8_STAGE(PG8_SA(1, 0), cA + kstep, voffA); PG8_STAGE(PG8_SB(1, 1), cB + hstep + kstep, voffB);
        PG8_WAIT_V(6); PG8_BAR;
    }
    for (;;) {
        const bool has_next = S.next(ui + 1, nxt);
        const PG8_GAS char* nA = has_next ? (const PG8_GAS char*)g.A + (size_t)nxt.pm * tstep + k0off : cA; const PG8_GAS char* nB = has_next ? (const PG8_GAS char*)g.Bt + (size_t)nxt.pn * tstep + k0off : cB;
        for (int t = 0; t < nt; t += 2) {
            const bool last = (t == nt - 2);
            const PG8_GAS char* a1 = cA + (ptrdiff_t)(t + 1) * kstep;
            const PG8_GAS char* a2 = last ? nA : cA + (ptrdiff_t)(t + 2) * kstep; const PG8_GAS char* b2 = last ? nB : cB + (ptrdiff_t)(t + 2) * kstep;
            const PG8_GAS char* a3 = a2 + kstep; const PG8_GAS char* b3 = b2 + kstep;
            if (last && has_next) S.a_ready(nxt);
            if constexpr (SP2) {
            PG8_LDB(B0, 0, 0); PG8_LDB(B1, 0, 1); PG8_SCHED; PG8_LDA(At, 0, 0); PG8_STAGE(PG8_SA(1, 1), a1 + hstep, voffA);
            PG8_WAIT_V(8); PG8_WAIT_L(0); PG8_BAR; PG8_MMA(0, 0, At, B0); PG8_MMA(0, 1, At, B1); PG8_BAR; PG8_SCHED;
            PG8_LDA(At, 0, 1); PG8_STAGE(PG8_SB(0, 0), b2, voffB); PG8_STAGE(PG8_SB(0, 1), b2 + hstep, voffB); PG8_STAGE(PG8_SA(0, 0), a2, voffA);
            PG8_WAIT_V(8); PG8_WAIT_L(0); PG8_BAR; PG8_MMA(1, 0, At, B0); PG8_MMA(1, 1, At, B1); PG8_BAR; PG8_SCHED;
            PG8_LDB(B0, 1, 0); PG8_LDB(B1, 1, 1); PG8_SCHED; PG8_LDA(At, 1, 0); PG8_STAGE(PG8_SA(0, 1), a2 + hstep, voffA);
            PG8_WAIT_V(8); PG8_WAIT_L(0); PG8_BAR; PG8_MMA(0, 0, At, B0); PG8_MMA(0, 1, At, B1); PG8_BAR; PG8_SCHED;
            PG8_LDA(At, 1, 1); PG8_STAGE(PG8_SB(1, 0), b3, voffB); PG8_STAGE(PG8_SB(1, 1), b3 + hstep, voffB); PG8_STAGE(PG8_SA(1, 0), a3, voffA);
            PG8_WAIT_V(8); PG8_WAIT_L(0); PG8_BAR; PG8_MMA(1, 0, At, B0); PG8_MMA(1, 1, At, B1); PG8_BAR; PG8_SCHED;
            } else {
            PG8_LDB(B0, 0, 0); PG8_SCHED; PG8_LDA(At, 0, 0); PG8_STAGE(PG8_SA(1, 1), a1 + hstep, voffA);
            PG8_WAIT_L(8); PG8_BAR; PG8_WAIT_L(0); PG8_MMA(0, 0, At, B0); PG8_BAR; PG8_SCHED;
            PG8_LDB(B1, 0, 1); PG8_STAGE(PG8_SB(0, 0), b2, voffB);
            PG8_BAR; PG8_WAIT_L(0); PG8_MMA(0, 1, At, B1); PG8_BAR;
            PG8_LDA(At, 0, 1); PG8_STAGE(PG8_SA(0, 0), a2, voffA);
            PG8_BAR; PG8_WAIT_L(0); PG8_MMA(1, 0, At, B0); PG8_BAR; PG8_SCHED;
            PG8_STAGE(PG8_SB(0, 1), b2 + hstep, voffB);
            PG8_WAIT_V(6); PG8_BAR; PG8_MMA(1, 1, At, B1); PG8_BAR;
            PG8_LDB(B0, 1, 0); PG8_SCHED; PG8_LDA(At, 1, 0); PG8_STAGE(PG8_SA(0, 1), a2 + hstep, voffA);
            PG8_WAIT_L(8); PG8_BAR; PG8_WAIT_L(0); PG8_MMA(0, 0, At, B0); PG8_BAR; PG8_SCHED;
            PG8_LDB(B1, 1, 1); PG8_STAGE(PG8_SB(1, 0), b3, voffB);
            PG8_BAR; PG8_WAIT_L(0); PG8_MMA(0, 1, At, B1); PG8_BAR;
            PG8_LDA(At, 1, 1); PG8_STAGE(PG8_SA(1, 0), a3, voffA);
            PG8_BAR; PG8_WAIT_L(0); PG8_MMA(1, 0, At, B0); PG8_BAR; PG8_SCHED;
            PG8_STAGE(PG8_SB(1, 1), b3 + hstep, voffB);
            PG8_WAIT_V(6); PG8_BAR; PG8_MMA(1, 1, At, B1); PG8_BAR;
            }
        }
        if constexpr (ALIGN_EPI) { if (wr == 0) PG8_BAR; }
        if constexpr (!Epi::AFTER_DRAIN) { if constexpr (Epi::ROW_RSTD_LDS) E(acc, cur, wr, wc, fr, fq, ui); else E(acc, cur, wr, wc, fr, fq); S.done(cur); }
        if (!has_next) break;
#pragma unroll
        for (int a = 0; a < 2; ++a)
#pragma unroll
            for (int b = 0; b < 2; ++b)
#pragma unroll
                for (int m = 0; m < 4; ++m)
#pragma unroll
                    for (int n = 0; n < 2; ++n) acc[a][b][m][n] = (f32x4){0.f, 0.f, 0.f, 0.f};
        cur = nxt; cA = nA; cB = nB; ++ui;
        if constexpr (ALIGN_EPI) { if (wr == 1) PG8_BAR; }
    }
    PG8_WAIT_V(0);
    if constexpr (!ALIGN_EPI) { if (wr == 0) PG8_BAR; }
    PG8_BAR;
#undef PG8_SA
#undef PG8_SB
#undef PG8_STAGE
#undef PG8_LDA
#undef PG8_LDB
#undef PG8_MMA
#undef PG8_WAIT_V
#undef PG8_WAIT_L
#undef PG8_BAR
#undef PG8_SCHED
}
}

constexpr int NWAVES = 8;
constexpr int DEPTH = 4, BATCH = 2, SEQ = 8192, D = 2048, FF = 5632, NGU = 2 * FF, INC = 4608, ZW = 3584, NVT = 1024;
constexpr int M = BATCH * SEQ;
constexpr int GRID_W = 64, GRID_ROWS = SEQ / GRID_W;
constexpr float NA_SCALE = 0.08838834764831845f;

constexpr size_t MiB = 1u << 20;
constexpr size_t WS_CTL = 0, CTL_ZERO_BYTES = 1 * MiB;
constexpr size_t WS_SSQ = 1 * MiB;
constexpr size_t WS_SGW = 2 * MiB;
constexpr size_t WS_PWT = 3 * MiB;
constexpr size_t WS_W = 4 * MiB;
constexpr size_t LW_GU1 = 0, LW_D1 = 44 * MiB, LW_IN = 66 * MiB, LW_OUT = 84 * MiB, LW_GU2 = 92 * MiB, LW_D2 = 136 * MiB, LW_BYTES = 158 * MiB;
constexpr size_t WS_XB = WS_W + DEPTH * LW_BYTES;
constexpr size_t WS_ACT = WS_XB + 64 * MiB;
constexpr size_t WS_Z = WS_ACT + 176 * MiB;
constexpr size_t WS_VT = WS_Z + 112 * MiB;
constexpr size_t WS_MIX = WS_VT + 32 * MiB;
constexpr size_t WS_END = WS_MIX + 64 * MiB;
static_assert((size_t)NGU * D * 2 == 44 * MiB && (size_t)D * FF * 2 == 22 * MiB && (size_t)INC * D * 2 == 18 * MiB && (size_t)D * D * 2 == 8 * MiB, "weight sizes");
static_assert((size_t)M * FF * 2 == 176 * MiB && (size_t)M * ZW * 2 == 112 * MiB, "activation sizes");
constexpr int CW_BAR = 4096;

constexpr int RING_OFF = 0, RING_BYTES = 131072;
constexpr int SCR_OFF = RING_BYTES;
constexpr int LDSCTL_OFF = SCR_OFF + 16384, MISC_OFF = LDSCTL_OFF + 320;
constexpr int LDS_BYTES = LDSCTL_OFF + 1024;
static_assert(pg8::RRL_MAX * 1024 <= 16384 && LDS_BYTES <= 163840, "LDS scratch");
static_assert(MISC_OFF + 128 <= LDS_BYTES, "LDS map");
constexpr int VT_PITCH = 272;
constexpr int RPB_OFF = 98304;

#define GAS __attribute__((address_space(1)))
#define LAS __attribute__((address_space(3)))
typedef unsigned short bf16;
typedef unsigned v4u __attribute__((ext_vector_type(4)));
typedef unsigned v2u __attribute__((ext_vector_type(2)));
typedef float f32x4 __attribute__((ext_vector_type(4)));
typedef float f32x2 __attribute__((ext_vector_type(2)));
typedef short bf16x8 __attribute__((ext_vector_type(8)));
typedef GAS unsigned gu32;
#define RLX_AGENT __ATOMIC_RELAXED, __HIP_MEMORY_SCOPE_AGENT
#define LDS_WAIT() asm volatile("s_waitcnt lgkmcnt(0)" ::: "memory")
#define VM_WAIT() asm volatile("s_waitcnt vmcnt(0)" ::: "memory")
__device__ __forceinline__ unsigned f2bf(float f) { unsigned u = __builtin_bit_cast(unsigned, f); return (u + 0x7fffu + ((u >> 16) & 1u)) >> 16; }
__device__ __forceinline__ unsigned pk2(float lo, float hi) { return f2bf(lo) | (f2bf(hi) << 16); }
__device__ __forceinline__ float bf_lo(unsigned w) { return __builtin_bit_cast(float, w << 16); }
__device__ __forceinline__ float bf_hi(unsigned w) { return __builtin_bit_cast(float, w & 0xffff0000u); }

#define XB_TMO      128
#define XB_XCNT(j)  (256  + 64 * (j))
#define XB_XSUB(j)  (1280 + 64 * (j))
#define XB_XGEN(j)  (2304 + 64 * (j))
#define XB_TOP      3328
#define XB_TOPGEN   3392
#define XCD_BAR_WORDS 3456
#define XB_SPIN_CAP (1u << 18)

typedef GAS unsigned* xbp;
__device__ __forceinline__ unsigned xb_ld(xbp p)              { return __hip_atomic_load(p, __ATOMIC_RELAXED, __HIP_MEMORY_SCOPE_AGENT); }
__device__ __forceinline__ unsigned xb_add(xbp p, unsigned v) { return __hip_atomic_fetch_add(p, v, __ATOMIC_RELAXED, __HIP_MEMORY_SCOPE_AGENT); }
__device__ __forceinline__ unsigned xb_xcc_id() { return (unsigned)__builtin_amdgcn_s_getreg((3 << 11) | 20) & 0xFu; }
#define XB_SPIN(cond, bar) do { unsigned _sp = 0; while (cond) { __builtin_amdgcn_s_sleep(1); \
    if ((++_sp & 255u) == 0u) { if (xb_ld(&(bar)[XB_TMO])) break; if (_sp > XB_SPIN_CAP) { xb_add(&(bar)[XB_TMO], 1u); break; } } } } while (0)

struct XcdBarrier {
    xbp bar; unsigned x;
    volatile LAS unsigned* st;
    bool t0;
};
__device__ __forceinline__ XcdBarrier xcd_barrier_post(xbp bar, volatile LAS unsigned* st) {
    XcdBarrier b; b.bar = bar; b.x = xb_xcc_id(); b.st = st; b.t0 = (threadIdx.x == 0);
    if (b.t0) (void)xb_add(&bar[XB_XCNT(b.x)], 1u);
    return b;
}
__device__ __forceinline__ void xcd_barrier_complete(xbp bar, unsigned x, unsigned& nloc, unsigned& nx) {
    const unsigned G = gridDim.x * gridDim.y * gridDim.z;
    unsigned sum, cnt, mine, sp = 0u;
    for (;;) {
        sum = 0u; cnt = 0u; mine = 0u;
#pragma unroll
        for (unsigned j = 0; j < 16; ++j) { const unsigned c = xb_ld(&bar[XB_XCNT(j)]); sum += c; cnt += (c > 0u) ? 1u : 0u; mine = (j == x) ? c : mine; }
        if (sum == G) break;
        __builtin_amdgcn_s_sleep(1);
        if ((++sp & 255u) == 0u) { if (xb_ld(&bar[XB_TMO])) break; if (sp > XB_SPIN_CAP) { xb_add(&bar[XB_TMO], 1u); break; } }
    }
    nloc = mine > 0u ? mine : 1u; nx = cnt > 0u ? cnt : 1u;
}
__device__ __forceinline__ void xcd_barrier(const XcdBarrier& b) {
    asm volatile("s_waitcnt vmcnt(0)" ::: "memory");
    __syncthreads();
    if (b.t0) {
        xbp bar = b.bar;
        __builtin_amdgcn_s_waitcnt(0);
        unsigned nloc = b.st[0], nx = b.st[1];
        if (nloc == 0u) { xcd_barrier_complete(bar, b.x, nloc, nx); b.st[0] = nloc; b.st[1] = nx; }
        const unsigned old = xb_add(&bar[XB_XSUB(b.x)], 1u);
        const unsigned gen = old / nloc;
        if (old + 1u == (gen + 1u) * nloc) {
            __builtin_amdgcn_fence(__ATOMIC_RELEASE, "agent");
            asm volatile("s_waitcnt vmcnt(0)" ::: "memory");
            const unsigned og = xb_add(&bar[XB_TOP], 1u);
            const unsigned tg = og / nx;
            if (og + 1u == (tg + 1u) * nx) xb_add(&bar[XB_TOPGEN], 1u);
            else XB_SPIN(xb_ld(&bar[XB_TOPGEN]) == tg, bar);
            __builtin_amdgcn_fence(__ATOMIC_ACQUIRE, "agent");
            xb_add(&bar[XB_XGEN(b.x)], 1u);
            asm volatile("s_waitcnt vmcnt(0)" ::: "memory");
        } else {
            XB_SPIN(xb_ld(&bar[XB_XGEN(b.x)]) == gen, bar);
            __builtin_amdgcn_fence(__ATOMIC_ACQUIRE, "agent");
            asm volatile("s_waitcnt vmcnt(0)" ::: "memory");
        }
    }
    __syncthreads();
}

typedef GAS unsigned char* gptr;
typedef const GAS float* gcf32;
typedef GAS bf16* gbf;
typedef const GAS bf16* gcbf;
struct Args { const float* in[19]; float* out; unsigned char* ws; };
typedef const __attribute__((address_space(4))) Args* kargp;
struct Frame {
    LAS unsigned char* lds;
    int tid, lane, wave;
    int G, bid;
    GAS float* X;
    gptr ws;
    kargp ap;
    __device__ __forceinline__ gbf XB() const { return (gbf)(ws + WS_XB); }
    __device__ __forceinline__ gbf ACT() const { return (gbf)(ws + WS_ACT); }
    __device__ __forceinline__ gbf Z() const { return (gbf)(ws + WS_Z); }
    __device__ __forceinline__ gbf VT() const { return (gbf)(ws + WS_VT); }
    __device__ __forceinline__ gbf MIX() const { return (gbf)(ws + WS_MIX); }
    __device__ __forceinline__ gbf SGW() const { return (gbf)(ws + WS_SGW); }
    __device__ __forceinline__ gbf PWT() const { return (gbf)(ws + WS_PWT); }
    __device__ __forceinline__ GAS float* SSQ() const { return (GAS float*)(ws + WS_SSQ); }
};
#define ARG_IN(k) ((gcf32)F.ap->in[k])

__device__ __forceinline__ float wave_sum(float v) {
#pragma unroll
    for (int o = 1; o < 64; o <<= 1) v += __shfl_xor(v, o);
    return v;
}

__device__ __forceinline__ void p0_transpose_item(gcf32 W, int K, int N, gbf WT, int rowmode, gcf32 gain, LAS float* scr, int item, int lane) {
    const int nblk = N / 32, kb = item / nblk, nb = item % nblk, k0 = 64 * kb, n0 = 32 * nb;
    int rowbase = n0;
    if (rowmode == 1) rowbase = 256 * (n0 >> 7) + (n0 & 127);
    if (rowmode == 2) rowbase = 256 * (n0 >> 7) + 128 + (n0 & 127);
#pragma unroll 8
    for (int i = 0; i < 32; ++i) { const int kk = 2 * i + (lane >> 5); float v = W[(size_t)(k0 + kk) * N + n0 + (lane & 31)]; if (gain) v *= gain[k0 + kk]; scr[kk * 33 + (lane & 31)] = v; }
    LDS_WAIT(); asm volatile("" ::: "memory");
    const int c = lane & 7;
#pragma unroll
    for (int j = 0; j < 4; ++j) { const int n = (lane >> 3) + 8 * j; const LAS float* s = scr + (8 * c) * 33 + n;
        v4u o; o.x = pk2(s[0 * 33], s[1 * 33]); o.y = pk2(s[2 * 33], s[3 * 33]); o.z = pk2(s[4 * 33], s[5 * 33]); o.w = pk2(s[6 * 33], s[7 * 33]);
        *(GAS v4u*)(WT + (size_t)(rowbase + n) * K + k0 + 8 * c) = o; }
    LDS_WAIT(); asm volatile("" ::: "memory");
}

struct P0Tile { gcf32 W; gcf32 gain; gbf WT; int K, N, rowmode, k0, n0, has_gain; };
constexpr int P0_SLOT = 8192 + 256;
static_assert(NWAVES * 2 * P0_SLOT <= LDSCTL_OFF, "prologue slots fit below the LDS control words");
constexpr int P0_T_G = (D / 64) * (FF / 256), P0_T_D = (FF / 64) * (D / 256), P0_T_IN = (D / 64) * (INC / 256), P0_T_OUT = (D / 64) * (D / 256);
constexpr int P0_PER_LAYER = 4 * P0_T_G + 2 * P0_T_D + P0_T_IN + P0_T_OUT, P0_TOTAL = DEPTH * P0_PER_LAYER;
__device__ __forceinline__ void p0_tile_decode(const Frame& F, int T, P0Tile& t) {
    constexpr int T_G = P0_T_G, T_D = P0_T_D, T_IN = P0_T_IN, T_OUT = P0_T_OUT;
    const int l = T / P0_PER_LAYER; int r = T % P0_PER_LAYER;
    gptr wl = F.ws + WS_W + (size_t)l * LW_BYTES; const size_t oG = (size_t)l * D * FF;
    int nblk;
    if (r < T_G)                { t.W = ARG_IN(2) + oG;  t.gain = ARG_IN(1) + l * D;  t.WT = (gbf)(wl + LW_GU1); t.K = D;  t.N = FF;  t.rowmode = 1; }
    else if ((r -= T_G) < T_G)  { t.W = ARG_IN(3) + oG;  t.gain = ARG_IN(1) + l * D;  t.WT = (gbf)(wl + LW_GU1); t.K = D;  t.N = FF;  t.rowmode = 2; }
    else if ((r -= T_G) < T_D)  { t.W = ARG_IN(4) + oG;  t.gain = ARG_IN(4) + oG;     t.WT = (gbf)(wl + LW_D1);  t.K = FF; t.N = D;   t.rowmode = 0; }
    else if ((r -= T_D) < T_IN) { t.W = ARG_IN(6) + (size_t)l * D * INC; t.gain = ARG_IN(5) + l * D; t.WT = (gbf)(wl + LW_IN); t.K = D; t.N = INC; t.rowmode = 0; }
    else if ((r -= T_IN) < T_OUT) { t.W = ARG_IN(13) + (size_t)l * D * D; t.gain = ARG_IN(13);  t.WT = (gbf)(wl + LW_OUT); t.K = D;  t.N = D;   t.rowmode = 0; }
    else if ((r -= T_OUT) < T_G) { t.W = ARG_IN(15) + oG; t.gain = ARG_IN(14) + l * D; t.WT = (gbf)(wl + LW_GU2); t.K = D;  t.N = FF;  t.rowmode = 1; }
    else if ((r -= T_G) < T_G)  { t.W = ARG_IN(16) + oG; t.gain = ARG_IN(14) + l * D; t.WT = (gbf)(wl + LW_GU2); t.K = D;  t.N = FF;  t.rowmode = 2; }
    else { r -= T_G;              t.W = ARG_IN(17) + oG; t.gain = ARG_IN(17) + oG;    t.WT = (gbf)(wl + LW_D2);  t.K = FF; t.N = D;   t.rowmode = 0; }
    t.has_gain = (t.rowmode != 0) || (t.N == INC);
    nblk = t.N / 256; t.k0 = 64 * (r / nblk); t.n0 = 256 * (r % nblk);
}
__device__ __forceinline__ void p0_strip_issue(const P0Tile& t, int w, int lane, LAS unsigned char* slot) {
    gcf32 src = t.W + (size_t)(t.k0 + (lane >> 3)) * t.N + t.n0 + 32 * w;
#pragma unroll
    for (int j = 0; j < 8; ++j) __builtin_amdgcn_global_load_lds((const GAS unsigned*)(src + (size_t)(8 * j) * t.N + 4 * ((lane & 7) ^ j)), (LAS unsigned*)(slot + j * 1024), 16, 0, 0);
    __builtin_amdgcn_global_load_lds((const GAS unsigned*)(t.gain + t.k0 + lane), (LAS unsigned*)(slot + 8192), 4, 0, 0);
}
__device__ __forceinline__ void p0_strip_finish(const P0Tile& t, int w, int lane, const LAS unsigned char* slot) {
    const int k8 = lane & 7, nl = lane >> 3;
    float g[8];
    { const f32x4 ga = *(const LAS f32x4*)(slot + 8192 + 32 * k8), gb = *(const LAS f32x4*)(slot + 8192 + 32 * k8 + 16);
      g[0] = ga.x; g[1] = ga.y; g[2] = ga.z; g[3] = ga.w; g[4] = gb.x; g[5] = gb.y; g[6] = gb.z; g[7] = gb.w;
#pragma unroll
      for (int i = 0; i < 8; ++i) g[i] = t.has_gain ? g[i] : 1.f; }
#pragma unroll
    for (int q = 0; q < 4; ++q) { const int n = nl + 8 * q;
        const LAS float* s = (const LAS float*)slot + (8 * k8) * 32 + 4 * ((n >> 2) ^ k8) + (n & 3);
        v4u o; o.x = pg8::cvt_pk_bf16(s[0] * g[0], s[32] * g[1]); o.y = pg8::cvt_pk_bf16(s[64] * g[2], s[96] * g[3]);
        o.z = pg8::cvt_pk_bf16(s[128] * g[4], s[160] * g[5]); o.w = pg8::cvt_pk_bf16(s[192] * g[6], s[224] * g[7]);
        const int nn = t.n0 + 32 * w + n; int row = nn;
        if (t.rowmode == 1) row = 256 * (nn >> 7) + (nn & 127);
        if (t.rowmode == 2) row = 256 * (nn >> 7) + 128 + (nn & 127);
        *(GAS v4u*)(t.WT + (size_t)row * t.K + t.k0 + 8 * k8) = o; }
}

__device__ __forceinline__ void p0_convert_tiles(Frame& F, int first, int stride, int nT) {
    LAS unsigned char* slot0 = F.lds + RING_OFF + F.wave * (2 * P0_SLOT); LAS unsigned char* slot1 = slot0 + P0_SLOT;
    P0Tile ta, tb; const int w = F.wave;
    p0_tile_decode(F, first, ta); p0_strip_issue(ta, w, F.lane, slot0);
    for (int i = 0; i < nT; i += 2) {
        p0_tile_decode(F, first + min(i + 1, nT - 1) * stride, tb); p0_strip_issue(tb, w, F.lane, slot1);
        asm volatile("s_waitcnt vmcnt(9)" ::: "memory");
        p0_strip_finish(ta, w, F.lane, slot0);
        if (i + 1 >= nT) break;
        p0_tile_decode(F, first + min(i + 2, nT - 1) * stride, ta); p0_strip_issue(ta, w, F.lane, slot0);
        asm volatile("s_waitcnt vmcnt(9)" ::: "memory");
        p0_strip_finish(tb, w, F.lane, slot1);
    }
    VM_WAIT(); LDS_WAIT(); __builtin_amdgcn_s_barrier();
}
constexpr int P0_LATE_GRID = 256, P0_LATE_PER_WG = 18, P0_LATE_SLOTS = 3, P0_LATE_PER_SLOT = 128 * P0_LATE_PER_WG, P0_LATE = P0_LATE_SLOTS * P0_LATE_PER_SLOT;
static_assert(P0_TOTAL - P0_LATE >= 1 * P0_PER_LAYER && P0_TOTAL - P0_LATE + 1 * P0_LATE_PER_SLOT >= 2 * P0_PER_LAYER && P0_TOTAL - P0_LATE + 2 * P0_LATE_PER_SLOT >= 3 * P0_PER_LAYER, "slot l converts tiles of layers > l only");
__device__ __forceinline__ void p0_late_slot(Frame& F, int l) {
    if (F.G != P0_LATE_GRID || l >= P0_LATE_SLOTS || F.bid < 128) return;
    p0_convert_tiles(F, P0_TOTAL - P0_LATE + l * P0_LATE_PER_SLOT + (F.bid - 128), 128, P0_LATE_PER_WG);
}

__device__ __forceinline__ void p0_prologue(Frame& F) {
    { const int early = (F.G == P0_LATE_GRID) ? P0_TOTAL - P0_LATE : P0_TOTAL; const int c = F.bid, G = F.G;
      if (c < early) p0_convert_tiles(F, c, G, (early - c + G - 1) / G); }
    LAS float* scr = (LAS float*)(F.lds + RING_OFF + F.wave * 16384);
    const int gw = F.bid * NWAVES + F.wave, NGW = F.G * NWAVES;
    for (int it = gw; it < DEPTH * 4 * 8; it += NGW) { const int lg = it >> 3, sub = it & 7;
        p0_transpose_item(ARG_IN(10) + (size_t)lg * 16384, 128, 128, F.PWT() + (size_t)lg * 16384, 0, nullptr, scr, sub, F.lane); }
    { gcf32 sw = ARG_IN(8); const int gt = F.bid * (NWAVES * 64) + F.tid, NT = F.G * NWAVES * 64;
      for (int i = gt; i < DEPTH * 4 * 128 * 128 / 4; i += NT) { const f32x4 v = *(const GAS f32x4*)(sw + (size_t)i * 4); v2u o; o.x = pk2(v.x, v.y); o.y = pk2(v.z, v.w); *(GAS v2u*)(F.SGW() + (size_t)i * 4) = o; } }
    gcf32 x = ARG_IN(0);
    for (int m = gw; m < M; m += NGW) {
        const GAS f32x4* xr = (const GAS f32x4*)(x + (size_t)m * D) + F.lane; GAS v2u* brow = (GAS v2u*)(F.XB() + (size_t)m * D) + F.lane;
        float s = 0.f;
#pragma unroll
        for (int j = 0; j < 8; ++j) { const f32x4 v = xr[64 * j]; s += (v.x * v.x + v.y * v.y) + (v.z * v.z + v.w * v.w); v2u o; o.x = pk2(v.x, v.y); o.y = pk2(v.z, v.w); brow[64 * j] = o; }
        s = wave_sum(s);
        if (F.lane < 8) F.SSQ()[(size_t)m * 8 + F.lane] = (F.lane == 0) ? s : 0.f;
    }
}

constexpr int VT_IMG = 128 * VT_PITCH;
template <int NU> __device__ __forceinline__ void mix_gating_units(Frame& F, int l, int u0, int ustride) {
    const int h = u0 & 3;
    LAS unsigned char* vT = F.lds + RING_OFF;
    {
        const int pos = F.tid >> 2, cq = F.tid & 3;
        v4u w[NU][4];
#pragma unroll
        for (int e = 0; e < NU; ++e) { gcbf zv = F.Z() + (size_t)(((u0 + e * ustride) >> 2) * 128 + pos) * ZW + 512 + h * 128 + cq * 32;
#pragma unroll
            for (int i = 0; i < 4; ++i) w[e][i] = *(const GAS v4u*)(zv + 8 * i); }
        gcf32 gn = ARG_IN(7) + l * 512 + h * 128 + cq * 32;
        f32x4 gv[8];
#pragma unroll
        for (int c4 = 0; c4 < 8; ++c4) gv[c4] = *(const GAS f32x4*)(gn + 4 * c4);
#pragma unroll
        for (int e = 0; e < NU; ++e) {
            float v[32];
#pragma unroll
            for (int i = 0; i < 4; ++i)
#pragma unroll
                for (int k = 0; k < 4; ++k) { const unsigned ww = w[e][i][k]; const f32x2 gl = pg8::gelu_pk((f32x2){bf_lo(ww), bf_hi(ww)}); v[8 * i + 2 * k] = gl.x; v[8 * i + 2 * k + 1] = gl.y; }
            float ss = 0.f;
#pragma unroll
            for (int c = 0; c < 32; ++c) ss += v[c] * v[c];
            ss += __shfl_xor(ss, 1); ss += __shfl_xor(ss, 2);
            const float rstd = __builtin_amdgcn_rsqf(ss * (1.0f / 128.0f) + pg8::RMS_EPS);
#pragma unroll
            for (int c4 = 0; c4 < 8; ++c4)
#pragma unroll
                for (int k = 0; k < 4; ++k) { const int c = 4 * c4 + k; *(LAS unsigned short*)(vT + e * VT_IMG + (cq * 32 + c) * VT_PITCH + pos * 2) = (unsigned short)f2bf(v[c] * rstd * gv[c4][k]); }
        }
    }
    __syncthreads();
    {
        const int fr = F.lane & 15, fq = F.lane >> 4, p = 16 * F.wave + fr;
        gcbf wsrow = F.SGW() + ((size_t)(l * 4 + h) * 128 + p) * 128 + 8 * fq;
        bf16x8 bfrag[4];
#pragma unroll
        for (int ks = 0; ks < 4; ++ks) bfrag[ks] = *(const GAS bf16x8*)(wsrow + 32 * ks);
        const float bias = ARG_IN(9)[(l * 4 + h) * 128 + p];
        v2u zz[NU][8];
#pragma unroll
        for (int e = 0; e < NU; ++e) { gcbf zu = F.Z() + (size_t)(((u0 + e * ustride) >> 2) * 128 + p) * ZW + h * 128 + 4 * fq;
#pragma unroll
            for (int dt = 0; dt < 8; ++dt) zz[e][dt] = *(const GAS v2u*)(zu + 16 * dt); }
#pragma unroll
        for (int e = 0; e < NU; ++e) {
            f32x4 acc[8];
#pragma unroll
            for (int dt = 0; dt < 8; ++dt) acc[dt] = (f32x4){0.f, 0.f, 0.f, 0.f};
#pragma unroll
            for (int ks = 0; ks < 4; ++ks)
#pragma unroll
                for (int dt = 0; dt < 8; ++dt) { const bf16x8 afrag = *(const LAS bf16x8*)(vT + e * VT_IMG + (16 * dt + fr) * VT_PITCH + 64 * ks + 16 * fq);
                    acc[dt] = __builtin_amdgcn_mfma_f32_16x16x32_bf16(afrag, bfrag[ks], acc[dt], 0, 0, 0); }
            gbf o = F.MIX() + (size_t)(((u0 + e * ustride) >> 2) * 128 + p) * D + h * 128 + 4 * fq;
#pragma unroll
            for (int dt = 0; dt < 8; ++dt) { const v2u z2 = zz[e][dt];
                const f32x2 a0 = pg8::gelu_pk((f32x2){bf_lo(z2.x), bf_hi(z2.x)}), a1 = pg8::gelu_pk((f32x2){bf_lo(z2.y), bf_hi(z2.y)});
                v2u wv; wv.x = pg8::cvt_pk_bf16(a0.x * (acc[dt][0] + bias), a0.y * (acc[dt][1] + bias)); wv.y = pg8::cvt_pk_bf16(a1.x * (acc[dt][2] + bias), a1.y * (acc[dt][3] + bias));
                *(GAS v2u*)(o + 16 * dt) = wv; }
        }
    }
    __syncthreads();
}

constexpr int PL_PITCH = 272, PL_IMG = 32 * PL_PITCH, PL_SLOT = 2 * PL_IMG;
static_assert(NWAVES * PL_SLOT <= LDSCTL_OFF, "pool slots fit below the LDS control words");
template <int g, int NUN> __device__ __forceinline__ void mix_pool_units(Frame& F, int l, int u0, int ustride) {
    constexpr int half = 1 << g;
    int lane = F.lane; asm volatile("" : "+v"(lane));
    const int fr = lane & 15, fq = lane >> 4;
    LAS unsigned char* slot = F.lds + RING_OFF + F.wave * PL_SLOT;
    gcbf pw = F.PWT() + (size_t)(l * 4 + g) * 16384 + 8 * fq;
    {
        v4u rv[NUN][8];
#pragma unroll
        for (int e = 0; e < NUN; ++e) { const int tok0 = ((u0 + e * ustride) >> 2) * 16, b = tok0 >> 13, s0 = tok0 & (SEQ - 1);
            gcbf zrow = F.Z() + (size_t)(b * SEQ) * ZW + 1024 + g * 128 + 8 * (lane & 15);
#pragma unroll
            for (int i = 0; i < 8; ++i) { const int pos = min(max(s0 - half + 4 * i + (lane >> 4), 0), SEQ - 1); rv[e][i] = *(const GAS v4u*)(zrow + (size_t)pos * ZW); } }
        __builtin_amdgcn_sched_barrier(0);
#pragma unroll
        for (int e = 0; e < NUN; ++e)
#pragma unroll
            for (int i = 0; i < 8; ++i) *(LAS v4u*)(slot + e * PL_IMG + (4 * i + (lane >> 4)) * PL_PITCH + (lane & 15) * 16) = rv[e][i];
    }
    bf16x8 afr[2][8];
    { gcbf pk = pw + (size_t)fr * 128; asm volatile("" : "+v"(pk));
#pragma unroll
      for (int dt = 0; dt < 8; ++dt) afr[0][dt] = *(const GAS bf16x8*)(pk + 2048 * dt); }
    f32x4 acc[NUN][8];
#pragma unroll
    for (int e = 0; e < NUN; ++e)
#pragma unroll
        for (int dt = 0; dt < 8; ++dt) acc[e][dt] = (f32x4){0.f, 0.f, 0.f, 0.f};
    LDS_WAIT(); asm volatile("" ::: "memory");
    const LAS unsigned char* rbase = slot + fr * PL_PITCH + fq * 16;
#pragma unroll
    for (int ks = 0; ks < 4; ++ks) {
        if (ks + 1 < 4) { gcbf pk = pw + (size_t)fr * 128 + 32 * (ks + 1); asm volatile("" : "+v"(pk));
#pragma unroll
            for (int dt = 0; dt < 8; ++dt) afr[(ks + 1) & 1][dt] = *(const GAS bf16x8*)(pk + 2048 * dt); }
#pragma unroll
        for (int e = 0; e < NUN; ++e) { const int tok0 = ((u0 + e * ustride) >> 2) * 16, s = (tok0 & (SEQ - 1)) + fr;
            const int lo = max(s - half, 0), hi = min(s + half, SEQ); const float inv_cnt = 1.0f / (float)(hi - lo);
            const LAS unsigned char* rb = rbase + e * PL_IMG + ks * 64;
            v4u wv[2 * half];
#pragma unroll
            for (int j = 0; j < 2 * half; ++j) wv[j] = *(const LAS v4u*)(rb + j * PL_PITCH);
            const v4u pc4 = *(const LAS v4u*)(rb + half * PL_PITCH);
            float sum[8];
#pragma unroll
            for (int k = 0; k < 8; ++k) sum[k] = 0.f;
#pragma unroll
            for (int j = 0; j < 2 * half; ++j) { const int pos = s + j - half; const float f = ((pos >= 0) && (pos < SEQ)) ? 1.0f : 0.0f; const v4u w = wv[j];
#pragma unroll
                for (int k = 0; k < 4; ++k) { sum[2 * k] += f * bf_lo(w[k]); sum[2 * k + 1] += f * bf_hi(w[k]); } }
            v4u dfr;
#pragma unroll
            for (int k = 0; k < 4; ++k) dfr[k] = pg8::cvt_pk_bf16(sum[2 * k] * inv_cnt - bf_lo(pc4[k]), sum[2 * k + 1] * inv_cnt - bf_hi(pc4[k]));
            const bf16x8 bfrag = __builtin_bit_cast(bf16x8, dfr);
#pragma unroll
            for (int dt = 0; dt < 8; ++dt) acc[e][dt] = __builtin_amdgcn_mfma_f32_16x16x32_bf16(afr[ks & 1][dt], bfrag, acc[e][dt], 0, 0, 0);
            __builtin_amdgcn_sched_barrier(0);
        }
    }
    gcf32 sc = ARG_IN(11) + l * 512 + g * 128 + 4 * fq;
    f32x4 sv[8];
#pragma unroll
    for (int dt = 0; dt < 8; ++dt) sv[dt] = *(const GAS f32x4*)(sc + 16 * dt);
#pragma unroll
    for (int e = 0; e < NUN; ++e) { const int tok = ((u0 + e * ustride) >> 2) * 16 + fr; gbf o = F.MIX() + (size_t)tok * D + 512 + g * 128 + 4 * fq;
#pragma unroll
        for (int dt = 0; dt < 8; ++dt) { v2u w; w.x = pg8::cvt_pk_bf16(acc[e][dt][0] * sv[dt].x, acc[e][dt][1] * sv[dt].y); w.y = pg8::cvt_pk_bf16(acc[e][dt][2] * sv[dt].z, acc[e][dt][3] * sv[dt].w);
            *(GAS v2u*)(o + 16 * dt) = w; } }
}
template <int NUN> __device__ __forceinline__ void mix_pool_dispatch(Frame& F, int l, int u0, int ustride) {
    const int g = u0 & 3;
    if (g == 0) mix_pool_units<0, NUN>(F, l, u0, ustride); else if (g == 1) mix_pool_units<1, NUN>(F, l, u0, ustride); else if (g == 2) mix_pool_units<2, NUN>(F, l, u0, ustride); else mix_pool_units<3, NUN>(F, l, u0, ustride);
}

__device__ __forceinline__ int na_fk(int key) { return (key & 3) | (((key >> 3) & 3) << 2); }
__device__ __forceinline__ void na_issue(gcbf zk, gcbf vth, int kr, int wave, int lane, LAS unsigned char* buf) {
#pragma unroll
    for (int e = 0; e < 2; ++e) { const int inst = 2 * wave + e;
        { const int key = 4 * inst + (lane >> 4), c = (lane & 15) ^ na_fk(key);
          __builtin_amdgcn_global_load_lds((const GAS unsigned*)(zk + (size_t)(kr * GRID_W + key) * ZW + 8 * c), (LAS unsigned*)(buf + inst * 1024), 16, 0, 0); }
        { const int d = 8 * inst + (lane >> 3), c = (lane & 7) ^ ((d >> 1) & 7);
          __builtin_amdgcn_global_load_lds((const GAS unsigned*)(vth + (size_t)d * SEQ + kr * GRID_W + 8 * c), (LAS unsigned*)(buf + 16384 + inst * 1024), 16, 0, 0); } }
}
__device__ __forceinline__ void mix_na_unit(Frame& F, int unit) {
    const int b = unit >> 8, h = (unit >> 5) & 7, rq = unit & 31;
    const int fr = F.lane & 15, fq = F.lane >> 4;
    const int r = 4 * rq + (F.wave >> 1), i0 = 2 * (F.wave & 1);
    const int sr = min(max(r - 4, 0), GRID_ROWS - 8);
    const int kr_lo = min(max(4 * rq - 4, 0), GRID_ROWS - 8), kr_hi = min(max(4 * rq - 1, 0), GRID_ROWS - 8) + 7, nsteps = kr_hi - kr_lo + 1;
    const LAS float* rpb = (const LAS float*)(F.lds + RPB_OFF) + h * (15 * 31);
    gcbf zk = F.Z() + (size_t)(b * SEQ) * ZW + 2560 + h * 128;
    gcbf vth = F.VT() + (size_t)(b * 1024 + h * 128) * SEQ;
    LAS unsigned char* nab = F.lds + RING_OFF;
    bf16x8 qf[2][4];
#pragma unroll
    for (int ii = 0; ii < 2; ++ii) { gcbf qp = F.Z() + (size_t)(b * SEQ + r * GRID_W + 16 * (i0 + ii) + fr) * ZW + 1536 + h * 128 + 8 * fq;
#pragma unroll
        for (int ks = 0; ks < 4; ++ks) qf[ii][ks] = *(const GAS bf16x8*)(qp + 32 * ks); }
    f32x4 oacc[2][8]; float mrun[2], lrun[2];
#pragma unroll
    for (int ii = 0; ii < 2; ++ii) { mrun[ii] = -1e30f; lrun[ii] = 0.f;
#pragma unroll
        for (int dt = 0; dt < 8; ++dt) oacc[ii][dt] = (f32x4){0.f, 0.f, 0.f, 0.f}; }
    __syncthreads();
    na_issue(zk, vth, kr_lo, F.wave, F.lane, nab);
    for (int t = 0; t < nsteps; ++t) {
        asm volatile("s_waitcnt vmcnt(0)" ::: "memory"); __builtin_amdgcn_s_barrier(); asm volatile("" ::: "memory");
        if (t + 1 < nsteps) na_issue(zk, vth, kr_lo + t + 1, F.wave, F.lane, nab + ((t + 1) & 1) * 32768);
        const int kr = kr_lo + t;
        if (kr >= sr && kr <= sr + 7) {
            const LAS unsigned char* kb = nab + (t & 1) * 32768; const LAS unsigned char* vb = kb + 16384;
            const LAS float* rrow = rpb + (kr - r + 7) * 31;
#pragma unroll
            for (int ii = 0; ii < 2; ++ii) {
                const int i = i0 + ii, qc = 16 * i + fr;
                const int cb = (i == 0) ? 0 : (i == 1) ? 8 : (i == 2) ? 24 : 32;
                const int cs = min(max(qc - 8, 0), GRID_W - 16);
                bf16x8 kf[2][4]; float bias[8];
#pragma unroll
                for (int hh = 0; hh < 2; ++hh) { const int kcl = cb + 8 * (fr >> 2) + (fr & 3) + 4 * hh, fk = na_fk(kcl);
#pragma unroll
                    for (int ks = 0; ks < 4; ++ks) kf[hh][ks] = *(const LAS bf16x8*)(kb + kcl * 256 + (((4 * ks + fq) ^ fk) << 4)); }
#pragma unroll
                for (int k = 0; k < 8; ++k) { const int kc = cb + 8 * fq + k; bias[k] = rrow[min(max(kc - qc + 15, 0), 30)]; }
                __builtin_amdgcn_sched_barrier(0);
#pragma unroll
                for (int k = 0; k < 8; ++k) asm volatile("" : "+v"(bias[k]));
                f32x4 sa[2];
#pragma unroll
                for (int hh = 0; hh < 2; ++hh) { f32x4 a = (f32x4){0.f, 0.f, 0.f, 0.f};
#pragma unroll
                    for (int ks = 0; ks < 4; ++ks) a = __builtin_amdgcn_mfma_f32_16x16x32_bf16(kf[hh][ks], qf[ii][ks], a, 0, 0, 0);
                    sa[hh] = a; }
                float sv[8]; float mt = -1e30f;
#pragma unroll
                for (int hh = 0; hh < 2; ++hh)
#pragma unroll
                    for (int j = 0; j < 4; ++j) { const int kc = cb + 8 * fq + 4 * hh + j; const bool ok = (kc >= cs) && (kc < cs + 16);
                        const float x = ok ? (sa[hh][j] * NA_SCALE + bias[4 * hh + j]) : -1e30f; sv[4 * hh + j] = x; mt = fmaxf(mt, x); }
                mt = fmaxf(mt, __shfl_xor(mt, 16)); mt = fmaxf(mt, __shfl_xor(mt, 32));
                const float mnew = fmaxf(mrun[ii], mt), alpha = __builtin_amdgcn_exp2f((mrun[ii] - mnew) * 1.44269504089f);
                mrun[ii] = mnew;
                float e[8], ps = 0.f;
#pragma unroll
                for (int k = 0; k < 8; ++k) { e[k] = __builtin_amdgcn_exp2f((sv[k] - mnew) * 1.44269504089f); ps += e[k]; }
                lrun[ii] = lrun[ii] * alpha + ps;
                v4u pw; pw.x = pg8::cvt_pk_bf16(e[0], e[1]); pw.y = pg8::cvt_pk_bf16(e[2], e[3]); pw.z = pg8::cvt_pk_bf16(e[4], e[5]); pw.w = pg8::cvt_pk_bf16(e[6], e[7]);
                const bf16x8 pf = __builtin_bit_cast(bf16x8, pw);
#pragma unroll
                for (int dh = 0; dh < 2; ++dh) { bf16x8 vf[4];
#pragma unroll
                    for (int dq = 0; dq < 4; ++dq) { const int d = 16 * (4 * dh + dq) + fr; vf[dq] = *(const LAS bf16x8*)(vb + d * 128 + ((((cb >> 3) + fq) ^ ((d >> 1) & 7)) << 4)); }
                    __builtin_amdgcn_sched_barrier(0);
#pragma unroll
                    for (int dq = 0; dq < 4; ++dq) oacc[ii][4 * dh + dq] = __builtin_amdgcn_mfma_f32_16x16x32_bf16(vf[dq], pf, oacc[ii][4 * dh + dq] * alpha, 0, 0, 0); }
            }
        }
    }
#pragma unroll
    for (int ii = 0; ii < 2; ++ii) { float l = lrun[ii]; l += __shfl_xor(l, 16); l += __shfl_xor(l, 32); const float inv = 1.0f / l;
        gbf op = F.MIX() + (size_t)(b * SEQ + r * GRID_W + 16 * (i0 + ii) + fr) * D + 1024 + h * 128 + 4 * fq;
#pragma unroll
        for (int dt = 0; dt < 8; ++dt) { const f32x4 o = oacc[ii][dt]; v2u w; w.x = pg8::cvt_pk_bf16(o[0] * inv, o[1] * inv); w.y = pg8::cvt_pk_bf16(o[2] * inv, o[3] * inv); *(GAS v2u*)(op + 16 * dt) = w; } }
}

__device__ __forceinline__ void mix_phase(Frame& F, int l) {
    {
        constexpr int NUNITS = (M / 128) * 4;
        if ((F.G & 3) == 0) { for (int u = F.bid; u < NUNITS; u += 2 * F.G) { if (u + F.G < NUNITS) mix_gating_units<2>(F, l, u, F.G); else mix_gating_units<1>(F, l, u, 0); } }
        else for (int u = F.bid; u < NUNITS; u += F.G) mix_gating_units<1>(F, l, u, 0);
    }
    const int gw = F.bid * NWAVES + F.wave, NGW = F.G * NWAVES;
    {
        constexpr int NUNITS = (M / 16) * 4;
        if ((NGW & 3) == 0) { for (int u = gw; u < NUNITS; u += 2 * NGW) { if (u + NGW < NUNITS) mix_pool_dispatch<2>(F, l, u, NGW); else mix_pool_dispatch<1>(F, l, u, 0); } }
        else for (int u = gw; u < NUNITS; u += NGW) mix_pool_dispatch<1>(F, l, u, 0);
    }
    __syncthreads();
    { gcf32 rp = ARG_IN(12) + (size_t)l * (8 * 15 * 31); LAS float* t = (LAS float*)(F.lds + RPB_OFF);
      for (int i = F.tid; i < 8 * 15 * 31; i += NWAVES * 64) t[i] = rp[i]; }
    for (int u = F.bid; u < BATCH * 8 * (GRID_ROWS / 4); u += F.G) mix_na_unit(F, u);
    __syncthreads();
}

#define PHASE_FRAME(F) Frame F; { unsigned z_ = 0u; asm volatile("" : "+s"(z_)); int t_ = (int)__builtin_amdgcn_mbcnt_hi(~0u, __builtin_amdgcn_mbcnt_lo(~0u, z_)) + 64 * wave_id_; asm volatile("" : "+v"(t_)); kargp a_ = (kargp)__builtin_amdgcn_kernarg_segment_ptr(); asm volatile("" : "+s"(a_)); \
    F.lds = (LAS unsigned char*)lds; F.tid = t_; F.lane = t_ & 63; F.wave = __builtin_amdgcn_readfirstlane(t_ >> 6); { int g_ = (int)gridDim.x, c_ = (int)blockIdx.x; asm volatile("" : "+s"(g_), "+s"(c_)); F.G = g_; F.bid = c_; } F.ap = a_; F.X = (GAS float*)a_->out; F.ws = (gptr)a_->ws; }
__global__ void __launch_bounds__(NWAVES * 64, 2) mega_fwd(Args args) {
    extern __shared__ __attribute__((aligned(16))) unsigned char lds[];
    const int wave_id_ = __builtin_amdgcn_readfirstlane((int)threadIdx.x >> 6);
    for (int u = threadIdx.x; u < (LDS_BYTES - LDSCTL_OFF) / 4; u += NWAVES * 64) ((LAS unsigned*)((LAS unsigned char*)lds + LDSCTL_OFF))[u] = 0u;
    __syncthreads();
    (void)xcd_barrier_post((xbp)(args.ws + WS_CTL) + CW_BAR, (volatile LAS unsigned*)((LAS unsigned char*)lds + MISC_OFF) + 8);
#define GRID_BAR() do { kargp a_ = (kargp)__builtin_amdgcn_kernarg_segment_ptr(); asm volatile("" : "+s"(a_)); XcdBarrier b_; b_.bar = (xbp)((gptr)a_->ws + WS_CTL) + CW_BAR; b_.x = xb_xcc_id(); \
        b_.st = (volatile LAS unsigned*)((LAS unsigned char*)lds + MISC_OFF) + 8; unsigned z_ = 0u; asm volatile("" : "+s"(z_)); b_.t0 = (wave_id_ == 0) && (__builtin_amdgcn_mbcnt_hi(~0u, __builtin_amdgcn_mbcnt_lo(~0u, z_)) == 0u); xcd_barrier(b_); } while (0)

    { PHASE_FRAME(F); p0_prologue(F); }
    GRID_BAR();

    for (int s = 0; s < 2 * DEPTH; ++s) {
        const int l = s >> 1, j = s & 1;
        {
            PHASE_FRAME(F); gptr wl = F.ws + WS_W + (size_t)l * LW_BYTES;
            pg8::Gemm g{F.XB(), (gcbf)(wl + (j ? LW_GU2 : LW_GU1)), M, NGU, D}; pg8::StaticOrder S; S.init(M, NGU, F.G, F.bid, 8);
            pg8::EpiGateUp E{F.ACT(), FF, pg8::RowRstdLds{F.SSQ(), (LAS float*)(F.lds + SCR_OFF)}};
            pg8::gemm_phase<pg8::EpiGateUp, pg8::StaticOrder, true, true>(F.lds + RING_OFF, g, S, E, F.tid);
        }
        GRID_BAR();
        {
            PHASE_FRAME(F); gptr wl = F.ws + WS_W + (size_t)l * LW_BYTES;
            pg8::Gemm g{F.ACT(), (gcbf)(wl + (j ? LW_D2 : LW_D1)), M, D, FF}; pg8::StaticOrder S; S.init(M, D, F.G, F.bid);
            pg8::EpiResid E{(GAS float*)nullptr, F.XB(), F.SSQ(), 0.5f, (LAS float*)(F.lds + SCR_OFF), F.tid};
            pg8::gemm_phase<pg8::EpiResid, pg8::StaticOrder, true, true, true>(F.lds + RING_OFF, g, S, E, F.tid);
        }
        GRID_BAR();
        if (j == 0) {
            {
                PHASE_FRAME(F); gptr wl = F.ws + WS_W + (size_t)l * LW_BYTES;
                pg8::Gemm g{F.XB(), (gcbf)(wl + LW_IN), M, ZW, D}; pg8::StaticOrder S; S.init(M, ZW, F.G, F.bid);
                pg8::EpiZ E{F.Z(), ZW, pg8::RowRstdLds{F.SSQ(), (LAS float*)(F.lds + SCR_OFF)}};
                pg8::gemm_phase<pg8::EpiZ, pg8::StaticOrder, true, true>(F.lds + RING_OFF, g, S, E, F.tid);
            }
            {
                PHASE_FRAME(F); gptr wl = F.ws + WS_W + (size_t)l * LW_BYTES;
                pg8::Gemm g{(gcbf)(wl + LW_IN) + (size_t)ZW * D, F.XB(), NVT, M, D}; pg8::StaticOrder S; S.init(NVT, M, F.G, F.bid);
                pg8::EpiVT E{F.VT(), F.SSQ()};
                pg8::gemm_phase<pg8::EpiVT, pg8::StaticOrder, true, true>(F.lds + RING_OFF, g, S, E, F.tid);
            }
            { PHASE_FRAME(F); p0_late_slot(F, l); }
            GRID_BAR();
            { PHASE_FRAME(F); mix_phase(F, l); }
            GRID_BAR();
            {
                PHASE_FRAME(F); gptr wl = F.ws + WS_W + (size_t)l * LW_BYTES;
                pg8::Gemm g{F.MIX(), (gcbf)(wl + LW_OUT), M, D, D}; pg8::StaticOrder S; S.init(M, D, F.G, F.bid);
                pg8::EpiResid E{(GAS float*)nullptr, F.XB(), F.SSQ(), 1.0f, (LAS float*)(F.lds + SCR_OFF), F.tid};
                pg8::gemm_phase<pg8::EpiResid, pg8::StaticOrder, true, true>(F.lds + RING_OFF, g, S, E, F.tid);
            }
            GRID_BAR();
        }
    }
    {
        PHASE_FRAME(F);
        const int gw = F.bid * NWAVES + F.wave, NGW = F.G * NWAVES;
        const GAS f32x4* gp = (const GAS f32x4*)ARG_IN(18) + 2 * F.lane;
        f32x4 gv[4][2];
#pragma unroll
        for (int jj = 0; jj < 4; ++jj) { gv[jj][0] = gp[128 * jj]; gv[jj][1] = gp[128 * jj + 1]; }
        for (int m = gw; m < M; m += NGW) { const float rs = pg8::row_rstd(F.SSQ(), m);
            const GAS pg8::u32x4* xr = (const GAS pg8::u32x4*)(F.XB() + (size_t)m * D) + F.lane; GAS f32x4* orow = (GAS f32x4*)(F.X + (size_t)m * D) + 2 * F.lane;
            pg8::u32x4 xv[4];
#pragma unroll
            for (int jj = 0; jj < 4; ++jj) xv[jj] = xr[64 * jj];
#pragma unroll
            for (int jj = 0; jj < 4; ++jj) { const pg8::u32x4 x = xv[jj]; f32x4 y0, y1;
                y0[0] = __builtin_bit_cast(float, x.x << 16); y0[1] = __builtin_bit_cast(float, x.x & 0xffff0000u); y0[2] = __builtin_bit_cast(float, x.y << 16); y0[3] = __builtin_bit_cast(float, x.y & 0xffff0000u);
                y1[0] = __builtin_bit_cast(float, x.z << 16); y1[1] = __builtin_bit_cast(float, x.z & 0xffff0000u); y1[2] = __builtin_bit_cast(float, x.w << 16); y1[3] = __builtin_bit_cast(float, x.w & 0xffff0000u);
                orow[128 * jj] = y0 * rs * gv[jj][0]; orow[128 * jj + 1] = y1 * rs * gv[jj][1]; } }
    }
}

extern "C" void kernel_launch(void* const* d_in, const int* in_sizes, int n_in, void* d_out, int out_size, void* d_ws, size_t ws_size, hipStream_t stream) {
    static int grid = 0;
    if (grid == 0) {
        if (n_in != 19 || in_sizes[0] != M * D || out_size != M * D || ws_size < WS_END) { fprintf(stderr, "kernel_launch: unexpected shapes: n_in %d in0 %d out %d ws %zu (need %zu)\n", n_in, n_in > 0 ? in_sizes[0] : -1, out_size, ws_size, (size_t)WS_END); grid = -1; return; }
        int dev = 0, cus = 0, per_cu = 0;
        if (hipGetDevice(&dev) != hipSuccess || hipDeviceGetAttribute(&cus, hipDeviceAttributeMultiprocessorCount, dev) != hipSuccess) { fprintf(stderr, "kernel_launch: device query failed\n"); grid = -1; return; }
        if (hipFuncSetAttribute((const void*)mega_fwd, hipFuncAttributeMaxDynamicSharedMemorySize, LDS_BYTES) != hipSuccess) { fprintf(stderr, "kernel_launch: hipFuncSetAttribute failed\n"); grid = -1; return; }
        if (hipOccupancyMaxActiveBlocksPerMultiprocessor(&per_cu, (const void*)mega_fwd, NWAVES * 64, LDS_BYTES) != hipSuccess || per_cu < 1)
            fprintf(stderr, "kernel_launch: note: occupancy query reports %d workgroups per CU\n", per_cu);
        (void)hipGetLastError();
        grid = cus;
    }
    if (grid < 0) return;
    if (hipMemsetAsync((char*)d_ws + WS_CTL, 0, CTL_ZERO_BYTES, stream) != hipSuccess) { fprintf(stderr, "kernel_launch: memset failed\n"); return; }
    Args a{};
    for (int i = 0; i < 19; ++i) a.in[i] = (const float*)d_in[i];
    a.out = (float*)d_out; a.ws = (unsigned char*)d_ws;
    hipLaunchKernelGGL(mega_fwd, dim3(grid), dim3(NWAVES * 64), LDS_BYTES, stream, a);
    const hipError_t le = hipPeekAtLastError();
    if (le != hipSuccess) fprintf(stderr, "kernel_launch: launch failed: %s\n", hipGetErrorName(le));
}
```
